# Optimizing an MI355X kernel written in HIP

```python
import numpy as np
import jax, jax.numpy as jnp
from jax import lax

D_MODEL = 1024
BATCH = 8
SEQ = 4096
DEPTH = 4

HEAD_DIM = 64
N_HEADS = D_MODEL // HEAD_DIM
MIX_WIDTH = N_HEADS * HEAD_DIM
ROT_DIM = HEAD_DIM // 4
ROPE_THETA = 500000.0
BLK = 128
NORM_EPS = 1e-6
MASK_VALUE = -1e30
N_MIXERS = 4
SCALE = HEAD_DIM ** -0.5

SWA_KV = 4
SWA_WINDOW = 128
DIL_KV = 4
DIL_PATTERNS = ((128, 1), (512, 4), (2048, 16))
FOX_HEADS = N_HEADS
NSA_KV = 2
CMP_LEN = 32
CMP_STRIDE = 16
CMP_HIDDEN = 256
SEL_LEN = 64
SEL_TOPK = 8
NSA_WINDOW = 256
FORCED_SCORE = 1e4

kernel_name = "interleaved_hybrid_swa_dilated_fox_nsa"


def rms_norm(x, g):
    xf = x.astype(jnp.float32)
    y = xf * lax.rsqrt(jnp.mean(xf * xf, axis=-1, keepdims=True) + NORM_EPS)
    return (y * g.astype(jnp.float32)).astype(x.dtype)


def partial_rope(x, pos):
    half = ROT_DIM // 2
    inv = jnp.power(ROPE_THETA, -jnp.arange(half, dtype=jnp.float32) / half)
    ang = pos.astype(jnp.float32)[..., None] * inv
    cos = jnp.cos(ang)[:, :, None, :]
    sin = jnp.sin(ang)[:, :, None, :]
    xf = x.astype(jnp.float32)
    x1, x2, rest = xf[..., :half], xf[..., half:ROT_DIM], xf[..., ROT_DIM:]
    out = jnp.concatenate([x1 * cos - x2 * sin, x2 * cos + x1 * sin, rest], axis=-1)
    return out.astype(x.dtype)


def split_cols(t, sizes):
    return jnp.split(t, [int(c) for c in np.cumsum(sizes)[:-1]], axis=-1)


def masked_softmax(s, mask, axis):
    s = jnp.where(mask, s, MASK_VALUE)
    m = jnp.max(s, axis=axis, keepdims=True)
    p = jnp.where(mask, jnp.exp(s - m), 0.0)
    den = jnp.sum(p, axis=axis, keepdims=True)
    return p / jnp.maximum(den, 1e-30)


def banded_attention(q, k, v, max_dist, sink=None):
    B, S, H, Dh = q.shape
    G = k.shape[2]
    R = H // G
    nb = S // BLK
    n_prev = -(-max_dist // BLK)
    pad = n_prev * BLK
    kp = jnp.pad(k, ((0, 0), (pad, 0), (0, 0), (0, 0))).reshape(B, nb + n_prev, BLK, G, Dh)
    vp = jnp.pad(v, ((0, 0), (pad, 0), (0, 0), (0, 0))).reshape(B, nb + n_prev, BLK, G, Dh)
    kb = jnp.concatenate([kp[:, j:j + nb] for j in range(n_prev + 1)], axis=2)
    vb = jnp.concatenate([vp[:, j:j + nb] for j in range(n_prev + 1)], axis=2)
    qb = q.reshape(B, nb, BLK, G, R, Dh)
    s = jnp.einsum('bnqgrd,bnkgd->bngrqk', qb, kb).astype(jnp.float32) * SCALE
    qi = jnp.arange(BLK)
    ki = jnp.arange((n_prev + 1) * BLK) - pad
    dist = qi[:, None] - ki[None, :]
    band = (dist >= 0) & (dist <= max_dist)
    start = jnp.arange(nb) * BLK
    mask = band[None] & ((start[:, None] + ki[None, :]) >= 0)[:, None, :]
    mask = mask[None, :, None, None]
    s = jnp.where(mask, s, MASK_VALUE)
    m = jnp.max(s, axis=-1, keepdims=True)
    if sink is not None:
        sk = sink.astype(jnp.float32).reshape(1, 1, G, R, 1, 1)
        m = jnp.maximum(m, sk)
    p = jnp.where(mask, jnp.exp(s - m), 0.0)
    den = jnp.sum(p, axis=-1, keepdims=True)
    if sink is not None:
        den = den + jnp.exp(sk - m)
    o = jnp.einsum('bngrqk,bnkgd->bnqgrd', (p / den).astype(v.dtype), vb).reshape(B, S, H, Dh)
    lse = (m + jnp.log(den))[..., 0].transpose(0, 1, 4, 2, 3).reshape(B, S, H)
    return o, lse


def swa_sink_mixer(h, pos, w_in, sinks):
    B, S, _ = h.shape
    q, k, v, gate = split_cols(h @ w_in, [MIX_WIDTH, SWA_KV * HEAD_DIM, SWA_KV * HEAD_DIM, MIX_WIDTH])
    q = partial_rope(q.reshape(B, S, N_HEADS, HEAD_DIM), pos)
    k = partial_rope(k.reshape(B, S, SWA_KV, HEAD_DIM), pos)
    v = v.reshape(B, S, SWA_KV, HEAD_DIM)
    o, _ = banded_attention(q, k, v, SWA_WINDOW - 1, sinks)
    return o.reshape(B, S, MIX_WIDTH) * jax.nn.silu(gate)


def dilated_attention(q, k, v, window, dil):
    B, S, H, Dh = q.shape
    seg = dil * BLK
    Sp = -(-S // seg) * seg
    L = Sp // dil

    def to_sub(t):
        n = t.shape[2]
        t = jnp.pad(t, ((0, 0), (0, Sp - S), (0, 0), (0, 0)))
        t = t.reshape(B, L, dil, n, Dh).transpose(0, 2, 1, 3, 4)
        return t.reshape(B * dil, L, n, Dh)

    o, lse = banded_attention(to_sub(q), to_sub(k), to_sub(v), window // dil)
    o = o.reshape(B, dil, L, H, Dh).transpose(0, 2, 1, 3, 4).reshape(B, Sp, H, Dh)[:, :S]
    lse = lse.reshape(B, dil, L, H).transpose(0, 2, 1, 3).reshape(B, Sp, H)[:, :S]
    return o, lse


def dilated_mixer(h, pos, w_in):
    B, S, _ = h.shape
    per_group = [MIX_WIDTH, DIL_KV * HEAD_DIM, DIL_KV * HEAD_DIM]
    cols = split_cols(h @ w_in, per_group * len(DIL_PATTERNS) + [MIX_WIDTH])
    gate = cols[-1]
    outs, lses = [], []
    for gi, (window, dil) in enumerate(DIL_PATTERNS):
        q, k, v = cols[3 * gi:3 * gi + 3]
        q = partial_rope(q.reshape(B, S, N_HEADS, HEAD_DIM), pos)
        k = partial_rope(k.reshape(B, S, DIL_KV, HEAD_DIM), pos)
        v = v.reshape(B, S, DIL_KV, HEAD_DIM)
        o, lse = dilated_attention(q, k, v, window, dil)
        outs.append(o)
        lses.append(lse)
    w = jax.nn.softmax(jnp.stack(lses, axis=0), axis=0)
    o = jnp.sum(w[..., None].astype(outs[0].dtype) * jnp.stack(outs, axis=0), axis=0)
    return o.reshape(B, S, MIX_WIDTH) * jax.nn.silu(gate)


def fox_mixer(h, w_in, b_f):
    B, S, _ = h.shape
    H = FOX_HEADS
    q, k, v, f_logit, gate = split_cols(h @ w_in, [MIX_WIDTH, MIX_WIDTH, MIX_WIDTH, H, MIX_WIDTH])
    q = q.reshape(B, S, H, HEAD_DIM)
    k = k.reshape(B, S, H, HEAD_DIM)
    v = v.reshape(B, S, H, HEAD_DIM)
    logf = jax.nn.log_sigmoid(f_logit.astype(jnp.float32) + b_f.astype(jnp.float32))
    c = jnp.cumsum(logf, axis=1)
    nb = S // BLK
    qb = q.reshape(B, nb, BLK, H, HEAD_DIM).transpose(1, 0, 2, 3, 4)
    cb = c.reshape(B, nb, BLK, H).transpose(1, 0, 2, 3)
    ck = c.transpose(0, 2, 1)[:, :, None, :]
    kpos = jnp.arange(S)

    def block(args):
        qn, cn, n = args
        s = jnp.einsum('bqhd,bkhd->bhqk', qn, k).astype(jnp.float32) * SCALE
        s = s + cn.transpose(0, 2, 1)[..., None] - ck
        t = n * BLK + jnp.arange(BLK)
        p = masked_softmax(s, kpos[None, :] <= t[:, None], -1)
        return jnp.einsum('bhqk,bkhd->bqhd', p.astype(v.dtype), v)

    o = lax.map(block, (qb, cb, jnp.arange(nb)))
    o = o.transpose(1, 0, 2, 3, 4).reshape(B, S, MIX_WIDTH)
    return o * jax.nn.silu(gate)


def compress_blocks(t, pe, w1, w2):
    B, S, G, Dh = t.shape
    ns = S // CMP_STRIDE
    tb = t.reshape(B, ns, CMP_STRIDE, G, Dh)
    win = jnp.concatenate([tb[:, :-1], tb[:, 1:]], axis=2)
    win = win + pe[None, None, :, None, :].astype(t.dtype)
    flat = win.transpose(0, 1, 3, 2, 4).reshape(B, ns - 1, G, CMP_LEN * Dh)
    return jax.nn.gelu(flat @ w1) @ w2


def selection_overlap(n_cmp, n_sel):
    cs = np.arange(n_cmp) * CMP_STRIDE
    js = np.arange(n_sel) * SEL_LEN
    ov = np.minimum(cs[:, None] + CMP_LEN, js[None, :] + SEL_LEN) - np.maximum(cs[:, None], js[None, :])
    return (np.clip(ov, 0, None) / CMP_LEN).astype(np.float32)


def nsa_mixer(h, pos, w_in, cmp_pe_k, cmp_w1_k, cmp_w2_k, cmp_pe_v, cmp_w1_v, cmp_w2_v):
    B, S, _ = h.shape
    H, G = N_HEADS, NSA_KV
    R = H // G
    kvw = G * HEAD_DIM
    q, kc, vc, ks, vs, kw, vw, g_logit, gate = split_cols(
        h @ w_in, [MIX_WIDTH, kvw, kvw, kvw, kvw, kvw, kvw, 3 * H, MIX_WIDTH])
    q = partial_rope(q.reshape(B, S, H, HEAD_DIM), pos)
    k_cmp = compress_blocks(kc.reshape(B, S, G, HEAD_DIM), cmp_pe_k, cmp_w1_k, cmp_w2_k)
    v_cmp = compress_blocks(vc.reshape(B, S, G, HEAD_DIM), cmp_pe_v, cmp_w1_v, cmp_w2_v)
    n_cmp = k_cmp.shape[1]
    cmp_end = np.arange(n_cmp) * CMP_STRIDE + CMP_LEN - 1
    k_cmp = partial_rope(k_cmp, pos[:, cmp_end])
    cmp_end_j = jnp.asarray(cmp_end)
    n_sel = S // SEL_LEN
    k_sel_n = min(SEL_TOPK, n_sel)
    ks = partial_rope(ks.reshape(B, S, G, HEAD_DIM), pos)
    ks = ks.reshape(B, n_sel, SEL_LEN, G, HEAD_DIM).transpose(0, 3, 1, 2, 4)
    vs = vs.reshape(B, n_sel, SEL_LEN, G, HEAD_DIM).transpose(0, 3, 1, 2, 4)
    overlap = jnp.asarray(selection_overlap(n_cmp, n_sel))
    nb = S // BLK
    qb = q.reshape(B, nb, BLK, G, R, HEAD_DIM).transpose(1, 0, 2, 3, 4, 5)
    bi = jnp.arange(B)[:, None, None, None]
    gi = jnp.arange(G)[None, :, None, None]
    jsel = jnp.arange(n_sel)

    def block(args):
        qn, n = args
        t = n * BLK + jnp.arange(BLK)
        s = jnp.einsum('bqgrd,bcgd->bgrqc', qn, k_cmp).astype(jnp.float32) * SCALE
        p_cmp = masked_softmax(s, cmp_end_j[None, :] <= t[:, None], -1)
        o_cmp = jnp.einsum('bgrqc,bcgd->bqgrd', p_cmp.astype(v_cmp.dtype), v_cmp)
        imp = jnp.einsum('bgrqc,cj->bgqj', p_cmp, overlap)
        cur = t // SEL_LEN
        forced = (jsel[None, :] == 0) | (jsel[None, :] == cur[:, None])
        causal = jsel[None, :] <= cur[:, None]
        score = jnp.where(causal, jnp.where(forced, FORCED_SCORE, imp), MASK_VALUE)
        vals, idx = lax.top_k(score, k_sel_n)
        valid = vals > 0.5 * MASK_VALUE
        kg = ks[bi, gi, idx]
        vg = vs[bi, gi, idx]
        tok = idx[..., None] * SEL_LEN + jnp.arange(SEL_LEN)
        smask = valid[..., None] & (tok <= t[None, None, :, None, None])
        s2 = jnp.einsum('bqgrd,bgqkld->bgqrkl', qn, kg).astype(jnp.float32) * SCALE
        p_slc = masked_softmax(s2, smask[:, :, :, None], (-2, -1))
        o_slc = jnp.einsum('bgqrkl,bgqkld->bqgrd', p_slc.astype(vg.dtype), vg)
        return o_cmp, o_slc

    o_cmp, o_slc = lax.map(block, (qb, jnp.arange(nb)))
    o_cmp = o_cmp.transpose(1, 0, 2, 3, 4, 5).reshape(B, S, H, HEAD_DIM)
    o_slc = o_slc.transpose(1, 0, 2, 3, 4, 5).reshape(B, S, H, HEAD_DIM)
    kw = partial_rope(kw.reshape(B, S, G, HEAD_DIM), pos)
    vw = vw.reshape(B, S, G, HEAD_DIM)
    o_win, _ = banded_attention(q, kw, vw, NSA_WINDOW - 1)
    g = jax.nn.sigmoid(g_logit.astype(jnp.float32)).reshape(B, S, H, 3, 1).astype(h.dtype)
    o = g[:, :, :, 0] * o_cmp + g[:, :, :, 1] * o_slc + g[:, :, :, 2] * o_win
    return o.reshape(B, S, MIX_WIDTH) * jax.nn.silu(gate)


def setup_inputs(seed: int = 0) -> dict:
    key = jax.random.key(seed)
    ks = jax.random.split(key, 24)
    f32 = jnp.float32

    def w(k, shape):
        return jax.random.normal(k, shape, f32) * shape[0] ** -0.5

    def gain(k):
        return 1.0 + 0.05 * jax.random.normal(k, (D_MODEL,), f32)

    kvw = NSA_KV * HEAD_DIM
    in_a = 2 * MIX_WIDTH + 2 * SWA_KV * HEAD_DIM
    in_b = len(DIL_PATTERNS) * (MIX_WIDTH + 2 * DIL_KV * HEAD_DIM) + MIX_WIDTH
    in_c = 4 * MIX_WIDTH + FOX_HEADS
    in_d = 2 * MIX_WIDTH + 6 * kvw + 3 * N_HEADS
    return {
        "x": jax.random.normal(ks[0], (BATCH, SEQ, D_MODEL), f32),
        "positions": (jnp.arange(SEQ, dtype=jnp.int32)[None, :]
                      + jax.random.randint(ks[1], (BATCH, 1), 0, 4096, dtype=jnp.int32)),
        "norm_0": gain(ks[2]),
        "w_in_0": w(ks[3], (D_MODEL, in_a)),
        "sinks_0": 0.5 * jax.random.normal(ks[4], (N_HEADS,), f32),
        "w_out_0": w(ks[5], (MIX_WIDTH, D_MODEL)),
        "norm_1": gain(ks[6]),
        "w_in_1": w(ks[7], (D_MODEL, in_b)),
        "w_out_1": w(ks[8], (MIX_WIDTH, D_MODEL)),
        "norm_2": gain(ks[9]),
        "w_in_2": w(ks[10], (D_MODEL, in_c)),
        "b_f_2": 3.0 + 0.5 * jax.random.normal(ks[11], (FOX_HEADS,), f32),
        "w_out_2": w(ks[12], (MIX_WIDTH, D_MODEL)),
        "norm_3": gain(ks[13]),
        "w_in_3": w(ks[14], (D_MODEL, in_d)),
        "cmp_pe_k_3": 0.02 * jax.random.normal(ks[15], (CMP_LEN, HEAD_DIM), f32),
        "cmp_w1_k_3": w(ks[16], (CMP_LEN * HEAD_DIM, CMP_HIDDEN)),
        "cmp_w2_k_3": w(ks[17], (CMP_HIDDEN, HEAD_DIM)),
        "cmp_pe_v_3": 0.02 * jax.random.normal(ks[18], (CMP_LEN, HEAD_DIM), f32),
        "cmp_w1_v_3": w(ks[19], (CMP_LEN * HEAD_DIM, CMP_HIDDEN)),
        "cmp_w2_v_3": w(ks[20], (CMP_HIDDEN, HEAD_DIM)),
        "w_out_3": w(ks[21], (MIX_WIDTH, D_MODEL)),
        "final_norm": gain(ks[22]),
    }


def reference(x, positions, norm_0, w_in_0, sinks_0, w_out_0, norm_1, w_in_1, w_out_1,
              norm_2, w_in_2, b_f_2, w_out_2, norm_3, w_in_3, cmp_pe_k_3, cmp_w1_k_3,
              cmp_w2_k_3, cmp_pe_v_3, cmp_w1_v_3, cmp_w2_v_3, w_out_3, final_norm):
    layers = [
        (norm_0, lambda h: swa_sink_mixer(h, positions, w_in_0, sinks_0), w_out_0),
        (norm_1, lambda h: dilated_mixer(h, positions, w_in_1), w_out_1),
        (norm_2, lambda h: fox_mixer(h, w_in_2, b_f_2), w_out_2),
        (norm_3, lambda h: nsa_mixer(h, positions, w_in_3, cmp_pe_k_3, cmp_w1_k_3, cmp_w2_k_3,
                                     cmp_pe_v_3, cmp_w1_v_3, cmp_w2_v_3), w_out_3),
    ]
    for i in range(DEPTH):
        norm, mixer, w_out = layers[i % N_MIXERS]
        x = x + mixer(rms_norm(x, norm)) @ w_out
    return rms_norm(x, final_norm)
```

```cpp
#include <hip/hip_runtime.h>
#include <hip/hip_cooperative_groups.h>
#include <cstdint>
#include <cstdio>
#include <cmath>
#include <cstring>
namespace cg = cooperative_groups;
#define DBG_SWA 0
#define DBG_DIL 0
#define DBG_WIN 0
#define DBG_FOX 0
#define PROBE_SWA 0
#define PROBE_DIL 0
#define PROBE_MERGE 0
#define PROBE_FOX 0
#define PROBE_CMP 0
#define PROBE_SLC 0
#define PROBE_WIN 0
#define PROBE_GOUT 0
#define PROBE_PREP 0

#define DI __device__ __forceinline__
typedef unsigned short bf16_t;
typedef unsigned long long ull;
typedef short bf16x8 __attribute__((ext_vector_type(8)));
typedef short s16x4 __attribute__((ext_vector_type(4)));
typedef float f32x16 __attribute__((ext_vector_type(16)));
typedef float f32x4 __attribute__((ext_vector_type(4)));
typedef float f32x2 __attribute__((ext_vector_type(2)));
typedef unsigned u32x4 __attribute__((ext_vector_type(4)));
typedef unsigned u32x2 __attribute__((ext_vector_type(2)));
typedef __bf16 bf16x2_t __attribute__((ext_vector_type(2)));

constexpr int SEQ = 4096, NTOK = 8 * 4096;
constexpr int LDS_BYTES = 76800;
constexpr int LSTR = 72;

enum { K_NONE = 0, K_PLAIN, K_ROPE, K_VT, K_FLOG, K_GLOG, K_PLAINB };
enum { E_SEG = 0, E_OUT, E_GELU, E_CMP2 };

struct Seg { void* dst; int nb; int kind; int dlog; int ld; int nkv; float scale; };
struct TJob { const float* src; bf16_t* dst; const float* gain; int ksrc; int nsrc; int ndst; int map; int tile0; int blk; };

struct Params {
  const float* x; const int* pos;
  const float* w_out[4];
  const float* sinks; const float* b_f;
  const float* pe[2]; const float* w1[2];
  const float* final_norm;
  float* out;
  bf16_t* wt_in[4]; bf16_t* wt_out[4]; bf16_t* wt_c1[2]; bf16_t* wt_c2[2];
  float* cbp; float* cb; unsigned* bar; float* ssqp;
  f32x2* rope; bf16_t* xb; bf16_t* Q; bf16_t* Kb; bf16_t* Vt; bf16_t* G;
  float* lse; float* logf; float* gates; ull* selmask; bf16_t* hid; bf16_t* kcmp; bf16_t* vtcmp;
  Seg segs[4][12];
  TJob tj[12];
  int nseg[4]; int npad[4];
  int ntj; int ttiles;
  float inv_freq[8];
};

DI unsigned pack2(float a, float b) { f32x2 v = {a, b}; bf16x2_t r = __builtin_convertvector(v, bf16x2_t); return __builtin_bit_cast(unsigned, r); }
DI bf16_t f2bf(float a) { return (bf16_t)(pack2(a, 0.f) & 0xffffu); }
DI float bflo(unsigned v) { return __uint_as_float(v << 16); }
DI float bfhi(unsigned v) { return __uint_as_float(v & 0xffff0000u); }
DI f32x16 mfma32(bf16x8 a, bf16x8 b, f32x16 c) { return __builtin_amdgcn_mfma_f32_32x32x16_bf16(a, b, c, 0, 0, 0); }
DI int otid() { int t = threadIdx.x; asm volatile("" : "+v"(t)); return t; }
DI size_t blk(size_t row, int k, int R) { return ((size_t)(k >> 5) * R + row) * 32 + (k & 31); }
DI int crow(int i, int h) { return (i & 3) + 8 * (i >> 2) + 4 * h; }
DI float silu_f(float x) { return x / (1.f + __expf(-x)); }
DI float sigmoid_f(float x) { return 1.f / (1.f + __expf(-x)); }
DI float gelu_tanh(float x) { float y = 0.7978845608028654f * (x + 0.044715f * x * x * x); float e = __expf(2.f * y); float th = 1.f - 2.f / (e + 1.f); return 0.5f * x * (1.f + th); }
DI float logsigmoid_f(float z) { return fminf(z, 0.f) - __logf(1.f + __expf(-fabsf(z))); }

DI int srcmap(int map, int n, int nsrc) {
  if (map == 2) {
    if (n < 3072) return n; if (n < 4096) return n + 16; if (n < 4112) return n - 1024; return -1;
  }
  if (map == 3) {
    if (n < 1792) return n; if (n < 2816) return n + 48; if (n < 2864) return n - 1024; return -1;
  }
  return n < nsrc ? n : -1;
}

DI void prep_phase(const Params& p, char* smem) {
  const int tid = otid();
  float* tl = (float*)smem;
  for (int u = blockIdx.x; u < p.ttiles; u += gridDim.x) {
    int ji = 0;
    for (int q = 1; q < p.ntj; ++q) if (u >= p.tj[q].tile0) ji = q;
    const TJob j = p.tj[ji];
    const int tile = u - j.tile0; const int nnt = j.ndst >> 6; const int nt = tile % nnt, kt = tile / nnt;
    const int n0 = nt * 64, k0 = kt * 64;
    __syncthreads();
    {
      const int nn = (tid & 15) * 4; const int sc = srcmap(j.map, n0 + nn, j.nsrc);
      f32x4 v[4];
#pragma unroll
      for (int i = 0; i < 4; ++i) {
        const int kk = (tid >> 4) + 16 * i;
        v[i] = (f32x4){0.f, 0.f, 0.f, 0.f};
        if (sc >= 0) v[i] = *(const f32x4*)(j.src + (size_t)(k0 + kk) * j.nsrc + sc);
      }
#pragma unroll
      for (int i = 0; i < 4; ++i) {
        const int kk = (tid >> 4) + 16 * i;
        const float gn = j.gain ? j.gain[k0 + kk] : 1.f;
        tl[kk * 65 + nn] = v[i][0] * gn; tl[kk * 65 + nn + 1] = v[i][1] * gn; tl[kk * 65 + nn + 2] = v[i][2] * gn; tl[kk * 65 + nn + 3] = v[i][3] * gn;
      }
    }
    __syncthreads();
    {
      const int nn = tid >> 2, kc = (tid & 3) * 16;
      unsigned w[8];
#pragma unroll
      for (int q = 0; q < 8; ++q) w[q] = pack2(tl[(kc + 2 * q) * 65 + nn], tl[(kc + 2 * q + 1) * 65 + nn]);
      bf16_t* d = j.blk ? j.dst + blk(n0 + nn, k0 + kc, j.ndst) : j.dst + (size_t)(n0 + nn) * j.ksrc + k0 + kc;
      *(u32x4*)d = (u32x4){w[0], w[1], w[2], w[3]};
      *(u32x4*)(d + 8) = (u32x4){w[4], w[5], w[6], w[7]};
    }
  }
  for (int u = blockIdx.x; u < 64; u += gridDim.x) {
    const int kv = u >> 5, ch = u & 31; const float* pe = p.pe[kv]; const float* w1 = p.w1[kv];
    float acc = 0.f;
    for (int rr = 0; rr < 64; ++rr) { const int row = ch * 64 + rr; acc += pe[row] * w1[(size_t)row * 256 + tid]; }
    p.cbp[(kv * 32 + ch) * 256 + tid] = acc;
  }
  const size_t gsz = (size_t)gridDim.x * 256, gid = (size_t)blockIdx.x * 256 + tid;
  {
    const int lane = tid & 63; const int wv = blockIdx.x * 4 + (tid >> 6), nw = gridDim.x * 4;
    for (int t = wv; t < NTOK; t += nw) {
      float ss = 0.f;
#pragma unroll
      for (int hf = 0; hf < 2; ++hf) {
        const size_t off = (size_t)t * 1024 + hf * 512 + lane * 8;
        const f32x4 a = *(const f32x4*)(p.x + off), b = *(const f32x4*)(p.x + off + 4);
        *(u32x4*)(p.xb + blk(t, hf * 512 + lane * 8, NTOK)) = (u32x4){pack2(a[0], a[1]), pack2(a[2], a[3]), pack2(b[0], b[1]), pack2(b[2], b[3])};
        ss += a[0] * a[0] + a[1] * a[1] + a[2] * a[2] + a[3] * a[3] + b[0] * b[0] + b[1] * b[1] + b[2] * b[2] + b[3] * b[3];
      }
#pragma unroll
      for (int d = 1; d < 64; d <<= 1) ss += __shfl_xor(ss, d);
      if (lane < 8) p.ssqp[(size_t)t * 8 + lane] = lane == 0 ? ss : 0.f;
    }
  }
  for (size_t i = gid; i < (size_t)NTOK * 8; i += gsz) {
    const int t = (int)(i >> 3), k = (int)(i & 7);
    const float ang = (float)p.pos[t] * p.inv_freq[k];
    double rv = (double)ang * 0.15915494309189535; rv -= floor(rv);
    const float rf = (float)rv;
    p.rope[i] = (f32x2){__builtin_amdgcn_cosf(rf), __builtin_amdgcn_sinf(rf)};
  }
}

struct GemmJob {
  const bf16_t* A; const bf16_t* Bt; int lda; int K; int amode; int epi; int layer; int kv;
  const float* res; float* outp; bf16_t* xbp; float* ssq_out; int ablk; int bblk;
};

DI unsigned a_rowoff(const GemmJob& j, int row) {
  if (j.amode == 0) return (unsigned)row * (unsigned)j.lda;
  row = row < 4080 ? row : 4079;
  const int g = row & 1, bi = row >> 1, b = bi / 255, i = bi - b * 255;
  return (unsigned)(b * SEQ + 16 * i) * (unsigned)j.lda + g * 64;
}

constexpr int GSTAGE = 24576;
constexpr int RSTD_OFF = 73728;
#define RAW_BARRIER() do { asm volatile("s_waitcnt lgkmcnt(0)" ::: "memory"); __builtin_amdgcn_s_barrier(); } while (0)
typedef __attribute__((address_space(1))) const void* gptr_t;
typedef __attribute__((address_space(3))) void* lptr_t;

DI void gemm_tile(const Params& p, const GemmJob& j, int mt, int nt, char* smem) {
  const int tid = otid(), lane = tid & 63, wid = __builtin_amdgcn_readfirstlane(tid >> 6), r = lane & 31, h = lane >> 5;
  const int wn = wid & 1, wt = wid >> 1;
  float* rstd_s = (float*)(smem + RSTD_OFF);
  const int t0 = mt * 256, n0 = nt * 128;
  const int rl = lane >> 2, c8s = ((lane & 3) ^ ((lane >> 4) & 3)) * 8;
  const int nk = j.K >> 5;
  f32x16 acc[2][4];
#pragma unroll
  for (int a = 0; a < 2; ++a)
#pragma unroll
    for (int b = 0; b < 4; ++b)
#pragma unroll
      for (int i = 0; i < 16; ++i) acc[a][b][i] = 0.f;
  auto glds = [&](int kt, int stage) {
    char* sb = smem + stage * GSTAGE;
    const unsigned ko = j.amode ? (unsigned)((kt >> 1) * j.lda + (kt & 1) * 32) : (unsigned)(kt * 32);
#pragma unroll
    for (int q = 0; q < 2; ++q) {
      const int ch = q * 4 + wid;
      const bf16_t* src = j.bblk ? j.Bt + ((size_t)kt * j.bblk + n0 + 16 * ch + rl) * 32 + c8s : j.Bt + (size_t)(n0 + 16 * ch + rl) * j.K + kt * 32 + c8s;
      __builtin_amdgcn_global_load_lds((gptr_t)src, (lptr_t)(sb + ch * 1024), 16, 0, 0);
    }
#pragma unroll
    for (int q = 0; q < 4; ++q) {
      const int ch = q * 4 + wid;
      const bf16_t* src = j.ablk ? j.A + ((size_t)kt * j.ablk + t0 + 16 * ch + rl) * 32 + c8s : j.A + a_rowoff(j, t0 + 16 * ch + rl) + ko + c8s;
      __builtin_amdgcn_global_load_lds((gptr_t)src, (lptr_t)(sb + 8192 + ch * 1024), 16, 0, 0);
    }
  };
  const int fr = (r >> 2) & 3; const int o0 = (h ^ fr) * 16;
  __syncthreads();
  glds(0, 0);
  if (nk > 1) glds(1, 1);
  int st = 0, st2 = 2;
  for (int kt = 0; kt < nk; ++kt) {
    if (kt + 1 < nk) asm volatile("s_waitcnt vmcnt(6)" ::: "memory"); else asm volatile("s_waitcnt vmcnt(0)" ::: "memory");
    RAW_BARRIER();
    if (kt + 2 < nk) glds(kt + 2, st2);
    const char* sb = smem + st * GSTAGE;
#pragma unroll
    for (int ks = 0; ks < 2; ++ks) {
      const int off = ks ? (o0 ^ 32) : o0;
      bf16x8 wf[2], xf[4];
#pragma unroll
      for (int a = 0; a < 2; ++a) wf[a] = *(const bf16x8*)(sb + (64 * wn + 32 * a + r) * 64 + off);
#pragma unroll
      for (int b = 0; b < 4; ++b) xf[b] = *(const bf16x8*)(sb + 8192 + (128 * wt + 32 * b + r) * 64 + off);
#pragma unroll
      for (int a = 0; a < 2; ++a)
#pragma unroll
        for (int b = 0; b < 4; ++b) acc[a][b] = mfma32(wf[a], xf[b], acc[a][b]);
    }
    st = (st == 2) ? 0 : st + 1; st2 = (st2 == 2) ? 0 : st2 + 1;
  }
  __syncthreads();
  if (j.epi == E_SEG) {
    const float* sp = p.ssqp + (size_t)(t0 + tid) * 8;
    const f32x4 s0 = *(const f32x4*)sp, s1 = *(const f32x4*)(sp + 4);
    rstd_s[tid] = rsqrtf(((s0[0] + s0[1]) + (s0[2] + s0[3]) + (s1[0] + s1[1]) + (s1[2] + s1[3])) * (1.f / 1024.f) + 1e-6f);
    __syncthreads();
  }
  const int cb = n0 + 64 * wn;
  if (j.epi == E_SEG) {
    const Seg* sg = p.segs[j.layer]; const int nsg = p.nseg[j.layer];
    {
      int si = 0;
      for (int q = 1; q < nsg; ++q) if (cb >= sg[q].nb) si = q;
      const Seg s = sg[si]; const int hd = (cb - s.nb) >> 6;
      bf16_t* Ch = (bf16_t*)smem + wn * (256 * LSTR);
#pragma unroll
      for (int ni = 0; ni < 4; ++ni) {
        const int tl = 128 * wt + 32 * ni + r, t = t0 + tl; const float rs = rstd_s[tl];
#pragma unroll
        for (int mi = 0; mi < 2; ++mi) {
          float v[16];
#pragma unroll
          for (int i = 0; i < 16; ++i) v[i] = acc[mi][ni][i] * rs;
          if (s.kind == K_ROPE && mi == 0) {
#pragma unroll
            for (int i = 0; i < 4; ++i) {
              const f32x2 cs = p.rope[(size_t)t * 8 + 4 * h + i]; const float x1 = v[i], x2 = v[i + 4];
              v[i] = x1 * cs[0] - x2 * cs[1]; v[i + 4] = x2 * cs[0] + x1 * cs[1];
            }
          }
          if (s.kind == K_PLAIN || s.kind == K_ROPE || s.kind == K_PLAINB) {
#pragma unroll
            for (int g = 0; g < 4; ++g)
              *(u32x2*)(Ch + tl * LSTR + 32 * mi + 8 * g + 4 * h) = (u32x2){pack2(v[4 * g] * s.scale, v[4 * g + 1] * s.scale), pack2(v[4 * g + 2] * s.scale, v[4 * g + 3] * s.scale)};
          } else if (s.kind == K_VT) {
#pragma unroll
            for (int i = 0; i < 16; ++i) Ch[(32 * mi + crow(i, h)) * 264 + tl] = f2bf(v[i]);
          } else if (s.kind == K_FLOG) {
#pragma unroll
            for (int i = 0; i < 8; ++i) { const int hh = crow(i, h); if (hd == 0 && mi == 0) p.logf[(size_t)t * 16 + hh] = logsigmoid_f(v[i] + p.b_f[hh]); }
          } else if (s.kind == K_GLOG) {
#pragma unroll
            for (int i = 0; i < 16; ++i) { const int gg = 32 * mi + crow(i, h); if (hd == 0 && (mi == 0 || i < 8)) p.gates[(size_t)t * 48 + gg] = sigmoid_f(v[i]); }
          }
        }
      }
    }
    __syncthreads();
#pragma unroll 1
    for (int hb = 0; hb < 2; ++hb) {
      const int cb2 = n0 + 64 * hb; int si = 0;
      for (int q = 1; q < nsg; ++q) if (cb2 >= sg[q].nb) si = q;
      const Seg s = sg[si]; const int hd = (cb2 - s.nb) >> 6;
      const bf16_t* Ch = (const bf16_t*)smem + hb * (256 * LSTR);
      const int dil = 1 << s.dlog, L = SEQ >> s.dlog;
      if (s.kind == K_PLAIN || s.kind == K_ROPE) {
#pragma unroll
        for (int q = 0; q < 8; ++q) {
          const int idx = tid + 256 * q, row = idx >> 3, c = idx & 7, t = t0 + row;
          const int b = t >> 12, sq = t & 4095; const size_t rowp = (size_t)(b * dil + (sq & (dil - 1))) * L + (sq >> s.dlog);
          *(u32x4*)((bf16_t*)s.dst + rowp * s.ld + hd * 64 + 8 * c) = *(const u32x4*)(Ch + row * LSTR + 8 * c);
        }
      } else if (s.kind == K_PLAINB) {
#pragma unroll
        for (int q = 0; q < 8; ++q) {
          const int idx = tid + 256 * q, row = idx >> 3, c = idx & 7;
          *(u32x4*)((bf16_t*)s.dst + blk(t0 + row, hd * 64 + 8 * c, NTOK)) = *(const u32x4*)(Ch + row * LSTR + 8 * c);
        }
      } else if (s.kind == K_VT) {
#pragma unroll
        for (int q = 0; q < 8; ++q) {
          const int idx = tid + 256 * q, d = idx >> 5, tc = idx & 31, t = t0 + 8 * tc;
          const u32x4 val = *(const u32x4*)(Ch + d * 264 + 8 * tc);
          const int b = t >> 12, sq = t & 4095;
          if (s.dlog == 0) {
            *(u32x4*)((bf16_t*)s.dst + ((size_t)(b * s.nkv + hd) * 64 + d) * SEQ + sq) = val;
          } else {
            const int rem = idx & 31, rho = rem >> (5 - s.dlog), ck = rem & ((32 >> s.dlog) - 1);
            unsigned wv[4];
#pragma unroll
            for (int e = 0; e < 4; ++e) {
              const unsigned lo = Ch[d * 264 + rho + dil * (8 * ck + 2 * e)], hi = Ch[d * 264 + rho + dil * (8 * ck + 2 * e + 1)];
              wv[e] = lo | (hi << 16);
            }
            const int sq0 = t0 & 4095, b0 = t0 >> 12;
            *(u32x4*)((bf16_t*)s.dst + ((size_t)((b0 * dil + rho) * s.nkv + hd) * 64 + d) * L + (sq0 >> s.dlog) + 8 * ck) = (u32x4){wv[0], wv[1], wv[2], wv[3]};
          }
        }
      }
    }
  } else if (j.epi == E_OUT) {
    bf16_t* Cs = (bf16_t*)smem;
#pragma unroll
    for (int ni = 0; ni < 4; ++ni)
#pragma unroll
      for (int mi = 0; mi < 2; ++mi)
#pragma unroll
        for (int g = 0; g < 4; ++g)
          *(u32x2*)(Cs + (128 * wt + 32 * ni + r) * 136 + 64 * wn + 32 * mi + 8 * g + 4 * h) =
              (u32x2){pack2(acc[mi][ni][4 * g], acc[mi][ni][4 * g + 1]), pack2(acc[mi][ni][4 * g + 2], acc[mi][ni][4 * g + 3])};
    __syncthreads();
#pragma unroll 4
    for (int q = 0; q < 16; ++q) {
      const int idx = tid + 256 * q, row = idx >> 4, col = (idx & 15) * 8;
      const u32x4 av = *(const u32x4*)(Cs + row * 136 + col);
      bf16_t* xq = j.xbp + blk(t0 + row, n0 + col, NTOK);
      float rv[8];
      if (j.res) {
        const f32x4 r0 = *(const f32x4*)(j.res + (size_t)(t0 + row) * 1024 + n0 + col), r1 = *(const f32x4*)(j.res + (size_t)(t0 + row) * 1024 + n0 + col + 4);
        rv[0] = r0[0]; rv[1] = r0[1]; rv[2] = r0[2]; rv[3] = r0[3]; rv[4] = r1[0]; rv[5] = r1[1]; rv[6] = r1[2]; rv[7] = r1[3];
      } else {
        const u32x4 rb = *(const u32x4*)xq;
#pragma unroll
        for (int e = 0; e < 4; ++e) { rv[2 * e] = bflo(rb[e]); rv[2 * e + 1] = bfhi(rb[e]); }
      }
      float o[8]; float ss = 0.f;
#pragma unroll
      for (int e = 0; e < 4; ++e) { o[2 * e] = rv[2 * e] + bflo(av[e]); o[2 * e + 1] = rv[2 * e + 1] + bfhi(av[e]); ss += o[2 * e] * o[2 * e] + o[2 * e + 1] * o[2 * e + 1]; }
      *(u32x4*)xq = (u32x4){pack2(o[0], o[1]), pack2(o[2], o[3]), pack2(o[4], o[5]), pack2(o[6], o[7])};
#pragma unroll
      for (int d = 1; d < 16; d <<= 1) ss += __shfl_xor(ss, d);
      if ((tid & 15) == 0 && j.ssq_out) j.ssq_out[(size_t)(t0 + row) * 8 + nt] = ss;
    }
  } else if (j.epi == E_GELU) {
#pragma unroll
    for (int ni = 0; ni < 4; ++ni) {
      const int t = t0 + 128 * wt + 32 * ni + r;
      if (t < 4080) {
#pragma unroll
        for (int mi = 0; mi < 2; ++mi)
#pragma unroll
          for (int g = 0; g < 4; ++g) {
            const int n = cb + 32 * mi + 8 * g + 4 * h;
            const f32x4 bv = *(const f32x4*)(p.cb + j.kv * 256 + n);
            const float a0 = gelu_tanh(acc[mi][ni][4 * g] + bv[0]), a1 = gelu_tanh(acc[mi][ni][4 * g + 1] + bv[1]);
            const float a2 = gelu_tanh(acc[mi][ni][4 * g + 2] + bv[2]), a3 = gelu_tanh(acc[mi][ni][4 * g + 3] + bv[3]);
            *(u32x2*)(p.hid + ((size_t)j.kv * 4096 + t) * 256 + n) = (u32x2){pack2(a0, a1), pack2(a2, a3)};
          }
      }
    }
  } else {
    if (wn == 0) {
#pragma unroll
      for (int ni = 0; ni < 4; ++ni) {
        const int t = t0 + 128 * wt + 32 * ni + r;
        if (t < 4080) {
          const int g2 = t & 1, bi = t >> 1, b = bi / 255, ci = bi - b * 255;
#pragma unroll
          for (int mi = 0; mi < 2; ++mi) {
            float v[16];
#pragma unroll
            for (int i = 0; i < 16; ++i) v[i] = acc[mi][ni][i];
            if (j.kv == 0) {
              if (mi == 0) {
                const size_t tt = (size_t)b * SEQ + 16 * ci + 31;
#pragma unroll
                for (int i = 0; i < 4; ++i) {
                  const f32x2 cs = p.rope[tt * 8 + 4 * h + i]; const float x1 = v[i], x2 = v[i + 4];
                  v[i] = x1 * cs[0] - x2 * cs[1]; v[i + 4] = x2 * cs[0] + x1 * cs[1];
                }
              }
              bf16_t* dp = p.kcmp + ((size_t)(b * 2 + g2) * 256 + ci) * 64 + 32 * mi + 4 * h;
#pragma unroll
              for (int g = 0; g < 4; ++g) *(u32x2*)(dp + 8 * g) = (u32x2){pack2(v[4 * g], v[4 * g + 1]), pack2(v[4 * g + 2], v[4 * g + 3])};
            } else {
#pragma unroll
              for (int i = 0; i < 16; ++i) p.vtcmp[((size_t)(b * 2 + g2) * 64 + 32 * mi + crow(i, h)) * 256 + ci] = f2bf(v[i]);
            }
          }
        }
      }
    }
  }
}

DI void gemm_phase(const Params& p, const GemmJob& j, int nmt, int ntn, char* smem) {
  const int xcd = blockIdx.x & 7, jl = blockIdx.x >> 3, nloc = (gridDim.x + 7 - xcd) >> 3;
  const int ngroups = nmt >> 2; const int ngx = (ngroups - xcd + 7) >> 3;
  const int per = 4 * ntn, entries = ngx * per;
  for (int e = jl; e < entries; e += nloc) {
    const int gl = e / per, rem = e - gl * per, nt = rem >> 2, m8 = rem & 3;
    const int mt = (gl * 8 + xcd) * 4 + m8;
    gemm_tile(p, j, mt, nt, smem);
  }
}

template <int MODE, bool MASKED>
DI void attn_tile(const bf16_t* Ks, const bf16_t* Vs, const bf16x8 (&qf)[4], f32x16 (&o)[2], float& m, float& l,
                  int key0, int tq, int maxdist, const float* cn_lds, bool lanesel) {
  constexpr float L2E = 1.4426950408889634f;
  const float NINF = -__builtin_inff();
  const int lane = threadIdx.x & 63, r = lane & 31, h = lane >> 5;
  f32x16 s[2];
#pragma unroll
  for (int k2 = 0; k2 < 2; ++k2) {
#pragma unroll
    for (int i = 0; i < 16; ++i) s[k2][i] = 0.f;
#pragma unroll
    for (int ks = 0; ks < 4; ++ks) {
      const bf16x8 a = *(const bf16x8*)(Ks + (32 * k2 + r) * LSTR + 16 * ks + 8 * h);
      s[k2] = mfma32(a, qf[ks], s[k2]);
    }
  }
  if (MODE == 1) {
#pragma unroll
    for (int k2 = 0; k2 < 2; ++k2)
#pragma unroll
      for (int g = 0; g < 4; ++g) {
        const f32x4 cv = *(const f32x4*)(cn_lds + key0 + 32 * k2 + 8 * g + 4 * h);
#pragma unroll
        for (int e = 0; e < 4; ++e) s[k2][4 * g + e] = fmaf(s[k2][4 * g + e], L2E, cv[e]);
      }
  }
  float mx = NINF;
#pragma unroll
  for (int k2 = 0; k2 < 2; ++k2)
#pragma unroll
    for (int i = 0; i < 16; ++i) {
      float v = s[k2][i];
      if (MASKED) {
        const int tk = key0 + 32 * k2 + crow(i, h);
        const bool valid = (MODE == 0) ? ((tk <= tq) && (tq - tk <= maxdist)) : (tk <= tq);
        v = valid ? v : NINF; s[k2][i] = v;
      }
      mx = fmaxf(mx, v);
    }
  mx = fmaxf(mx, __shfl_xor(mx, 32));
  if (MODE != 1) mx *= L2E;
  if (MODE == 2) mx = lanesel ? mx : NINF;
  const float mn = fmaxf(m, mx); const float alpha = __builtin_amdgcn_exp2f(m - mn);
  const float neg = (MODE == 2 && !lanesel) ? NINF : -mn;
  float ps = 0.f;
#pragma unroll
  for (int k2 = 0; k2 < 2; ++k2)
#pragma unroll
    for (int i = 0; i < 16; ++i) {
      const float pv = (MODE == 1) ? __builtin_amdgcn_exp2f(s[k2][i] + neg) : __builtin_amdgcn_exp2f(fmaf(s[k2][i], L2E, neg));
      s[k2][i] = pv; ps += pv;
    }
  l = l * alpha + ps;
  if (__builtin_amdgcn_ballot_w64(mn != m) != 0ull) {
#pragma unroll
    for (int dt = 0; dt < 2; ++dt)
#pragma unroll
      for (int i = 0; i < 16; ++i) o[dt][i] *= alpha;
  }
  m = mn;
#pragma unroll
  for (int st = 0; st < 4; ++st) {
    const int k2 = st >> 1, b8 = 8 * (st & 1);
    const u32x4 pw = {pack2(s[k2][b8], s[k2][b8 + 1]), pack2(s[k2][b8 + 2], s[k2][b8 + 3]), pack2(s[k2][b8 + 4], s[k2][b8 + 5]), pack2(s[k2][b8 + 6], s[k2][b8 + 7])};
    const bf16x8 pb = __builtin_bit_cast(bf16x8, pw);
#pragma unroll
    for (int dt = 0; dt < 2; ++dt) {
      const s16x4 lo = *(const s16x4*)(Vs + (32 * dt + r) * LSTR + 16 * st + 4 * h);
      const s16x4 hi = *(const s16x4*)(Vs + (32 * dt + r) * LSTR + 16 * st + 8 + 4 * h);
      const bf16x8 a = __builtin_shufflevector(lo, hi, 0, 1, 2, 3, 4, 5, 6, 7);
      o[dt] = mfma32(a, pb, o[dt]);
    }
  }
}

template <int MODE>
DI void flash_loop(char* smem, const bf16_t* Kbase, size_t ldk, const bf16_t* Vtbase, size_t ldv, ull tiles, ull wtiles,
                   const bf16x8 (&qf)[4], f32x16 (&o)[2], float& m, float& l, int tq, int tqmin, int tqmax, int maxdist, const float* cn_lds, ull lmask) {
  const int tid = threadIdx.x; const int c8 = (tid & 7) * 8, lr = tid >> 3;
  if (!tiles) return;
  u32x4 ka[2], va[2], kb[2], vb[2];
  auto issue = [&](int kt, u32x4 (&rk)[2], u32x4 (&rv)[2]) {
#pragma unroll
    for (int q = 0; q < 2; ++q) { rk[q] = *(const u32x4*)(Kbase + (size_t)(64 * kt + lr + 32 * q) * ldk + c8); rv[q] = *(const u32x4*)(Vtbase + (size_t)(lr + 32 * q) * ldv + 64 * kt + c8); }
  };
  auto stash = [&](int stage, const u32x4 (&rk)[2], const u32x4 (&rv)[2]) {
    bf16_t* Ks = (bf16_t*)(smem + stage * (2 * 64 * LSTR * 2)); bf16_t* Vs = Ks + 64 * LSTR;
#pragma unroll
    for (int q = 0; q < 2; ++q) { *(u32x4*)(Ks + (lr + 32 * q) * LSTR + c8) = rk[q]; *(u32x4*)(Vs + (lr + 32 * q) * LSTR + c8) = rv[q]; }
  };
  auto next_tile = [&]() -> int { if (!tiles) return -1; const int t = __builtin_ctzll(tiles); tiles &= tiles - 1; return t; };
  auto compute = [&](int kt, int stage) {
    if (!((wtiles >> kt) & 1ull)) return;
    const bf16_t* Ks = (const bf16_t*)(smem + stage * (2 * 64 * LSTR * 2)); const bf16_t* Vs = Ks + 64 * LSTR;
    const bool sel = ((lmask >> kt) & 1ull) != 0;
    const bool interior = (64 * kt + 63 <= tqmin) && (MODE != 0 || (tqmax - 64 * kt <= maxdist));
    if (interior) attn_tile<MODE, false>(Ks, Vs, qf, o, m, l, 64 * kt, tq, maxdist, cn_lds, sel);
    else attn_tile<MODE, true>(Ks, Vs, qf, o, m, l, 64 * kt, tq, maxdist, cn_lds, sel);
  };
  int t0 = next_tile(); issue(t0, ka, va);
  int t1 = next_tile(); if (t1 >= 0) issue(t1, kb, vb);
  while (true) {
    stash(0, ka, va);
    __syncthreads();
    const int t2 = next_tile(); if (t2 >= 0) issue(t2, ka, va);
    compute(t0, 0);
    if (t1 < 0) break;
    stash(1, kb, vb);
    __syncthreads();
    const int t3 = next_tile(); if (t3 >= 0) issue(t3, kb, vb);
    compute(t1, 1);
    if (t2 < 0) break;
    t0 = t2; t1 = t3;
  }
}

DI ull tile_range(int lo, int hi) {
  const ull top = (hi >= 63) ? ~0ull : ((1ull << (hi + 1)) - 1ull);
  return top & ~((1ull << lo) - 1ull);
}

DI void load_q(const bf16_t* qp, bf16x8 (&qf)[4]) {
  const int h = (threadIdx.x & 63) >> 5;
#pragma unroll
  for (int ks = 0; ks < 4; ++ks) qf[ks] = *(const bf16x8*)(qp + 16 * ks + 8 * h);
}

DI void store_gated(const f32x16 (&o)[2], float inv, bf16_t* G, size_t tok, int head) {
  const int h = (otid() & 63) >> 5;
#pragma unroll
  for (int dt = 0; dt < 2; ++dt)
#pragma unroll
    for (int g = 0; g < 4; ++g) {
      bf16_t* q = G + blk(tok, head * 64 + 32 * dt + 8 * g + 4 * h, NTOK);
      const u32x2 gv = *(const u32x2*)q;
      const float a0 = o[dt][4 * g] * inv * silu_f(bflo(gv[0])), a1 = o[dt][4 * g + 1] * inv * silu_f(bfhi(gv[0]));
      const float a2 = o[dt][4 * g + 2] * inv * silu_f(bflo(gv[1])), a3 = o[dt][4 * g + 3] * inv * silu_f(bfhi(gv[1]));
      *(u32x2*)q = (u32x2){pack2(a0, a1), pack2(a2, a3)};
    }
}
DI void store_plain(const f32x16 (&o)[2], float inv, bf16_t* op) {
  const int h = (threadIdx.x & 63) >> 5;
#pragma unroll
  for (int dt = 0; dt < 2; ++dt)
#pragma unroll
    for (int g = 0; g < 4; ++g)
      *(u32x2*)(op + 32 * dt + 8 * g + 4 * h) = (u32x2){pack2(o[dt][4 * g] * inv, o[dt][4 * g + 1] * inv), pack2(o[dt][4 * g + 2] * inv, o[dt][4 * g + 3] * inv)};
}
DI void zero_o(f32x16 (&o)[2]) {
#pragma unroll
  for (int dt = 0; dt < 2; ++dt)
#pragma unroll
    for (int i = 0; i < 16; ++i) o[dt][i] = 0.f;
}


DI void naive_core(const bf16_t* qp, const bf16_t* Kbase, size_t ldk, const bf16_t* Vtbase, size_t ldv, int tq, int klo, int mode, const float* logf, size_t lfs,
                   float m0, float l0, float (&o)[64], float& m_out, float& l_out) {
#pragma unroll
  for (int d = 0; d < 64; ++d) o[d] = 0.f;
  float m = m0, l = l0, D = 0.f;
  for (int tk = tq; tk >= klo; --tk) {
    const bf16_t* kp = Kbase + (size_t)tk * ldk;
    float sc = 0.f;
#pragma unroll
    for (int d = 0; d < 64; d += 2) { const unsigned w = *(const unsigned*)(kp + d); const unsigned qw = *(const volatile unsigned*)(qp + d); sc += bflo(qw) * bflo(w) + bfhi(qw) * bfhi(w); }
    if (mode == 1) sc += D;
    const float mn = fmaxf(m, sc), al = __expf(m - mn), pv = __expf(sc - mn);
    l = l * al + pv; m = mn;
#pragma unroll
    for (int d = 0; d < 64; ++d) o[d] = o[d] * al + pv * bflo((unsigned)Vtbase[(size_t)d * ldv + tk]);
    if (mode == 1) D += logf[(size_t)tk * lfs];
  }
  m_out = m; l_out = l;
}
DI void swa_unit(const Params& p, int u, char* smem, bool probe = false) {
  const int tid = otid(), lane = tid & 63, w = __builtin_amdgcn_readfirstlane(tid >> 6), r = lane & 31, h = lane >> 5;
  const int chunk = u & 127, kvh = (u >> 7) & 3, b = u >> 9;
  const int q0 = chunk * 32, head = kvh * 4 + w, tq = q0 + r; const size_t tok = (size_t)b * SEQ + tq;
  __syncthreads();
  bf16x8 qf[4]; load_q(p.Q + tok * 1024 + head * 64, qf);
  f32x16 o[2]; zero_o(o);
  float m = p.sinks[head] * 1.4426950408889634f, l = (h == 0) ? 1.f : 0.f;
  int lo = (q0 - 127) >> 6; lo = lo < 0 ? 0 : lo; const int hi = (q0 + 31) >> 6;
  const ull tiles = tile_range(lo, hi);
  flash_loop<0>(smem, p.Kb + (size_t)b * SEQ * 256 + kvh * 64, 256, p.Vt + (size_t)(b * 4 + kvh) * 64 * SEQ, SEQ, tiles, tiles, qf, o, m, l, tq, q0, q0 + 31, 127, nullptr, 0ull);
  l += __shfl_xor(l, 32);
  store_gated(o, 1.f / l, p.G, tok, head);
}

DI void dil_unit(const Params& p, int gi, int dlog, int u, char* smem, bool probe = false) {
  const int tid = otid(), lane = tid & 63, w = __builtin_amdgcn_readfirstlane(tid >> 6), r = lane & 31, h = lane >> 5;
  const int L = SEQ >> dlog, nch = L >> 5;
  const int chunk = u % nch, kvh = (u / nch) & 3, bq = u / (nch * 4);
  const int q0 = chunk * 32, head = kvh * 4 + w, tq = q0 + r; const size_t row = (size_t)bq * L + tq;
  __syncthreads();
  bf16_t* Qg = p.Q + (size_t)gi * NTOK * 1024;
  bf16x8 qf[4]; load_q(Qg + row * 1024 + head * 64, qf);
  f32x16 o[2]; zero_o(o);
  float m = -1e30f, l = 0.f;
  int lo = (q0 - 128) >> 6; lo = lo < 0 ? 0 : lo; const int hi = (q0 + 31) >> 6;
  const ull tiles = tile_range(lo, hi);
  flash_loop<0>(smem, p.Kb + (size_t)gi * NTOK * 256 + (size_t)bq * L * 256 + kvh * 64, 256, p.Vt + (size_t)gi * NTOK * 256 + (size_t)(bq * 4 + kvh) * 64 * L, L, tiles, tiles, qf, o, m, l, tq, q0, q0 + 31, 128, nullptr, 0ull);
  l += __shfl_xor(l, 32);
  store_plain(o, 1.f / l, probe ? p.xb + (row & (NTOK - 1)) * 1024 + head * 64 : Qg + row * 1024 + head * 64);
  if (h == 0 && !probe) p.lse[((size_t)gi * NTOK + row) * 16 + head] = m * 0.6931471805599453f + __logf(l);
}

DI void dil_merge_phase(const Params& p, bool probe = false) {
  const size_t gsz = (size_t)gridDim.x * 256, gid = (size_t)blockIdx.x * 256 + otid();
  for (size_t i = gid; i < (size_t)NTOK * 128; i += gsz) {
    const int t = (int)(i >> 7), c = (int)(i & 127), head = c >> 3;
    const int b = t >> 12, sq = t & 4095;
    size_t rows[3]; float ls[3];
#pragma unroll
    for (int gi = 0; gi < 3; ++gi) {
      const int dlog = 2 * gi, dil = 1 << dlog, L = SEQ >> dlog;
      rows[gi] = (size_t)b * SEQ + (size_t)(sq & (dil - 1)) * L + (sq >> dlog);
      ls[gi] = p.lse[((size_t)gi * NTOK + rows[gi]) * 16 + head];
    }
    const float mx = fmaxf(ls[0], fmaxf(ls[1], ls[2]));
    float wg[3]; float den = 0.f;
#pragma unroll
    for (int gi = 0; gi < 3; ++gi) { wg[gi] = __expf(ls[gi] - mx); den += wg[gi]; }
    const float inv = 1.f / den;
    float acc[8] = {0.f, 0.f, 0.f, 0.f, 0.f, 0.f, 0.f, 0.f};
#pragma unroll
    for (int gi = 0; gi < 3; ++gi) {
      const u32x4 ov = *(const u32x4*)(p.Q + (size_t)gi * NTOK * 1024 + rows[gi] * 1024 + c * 8);
      const float wq = wg[gi] * inv;
#pragma unroll
      for (int e = 0; e < 4; ++e) { acc[2 * e] += wq * bflo(ov[e]); acc[2 * e + 1] += wq * bfhi(ov[e]); }
    }
    bf16_t* gp = p.G + blk(t, c * 8, NTOK);
    const u32x4 gv = *(const u32x4*)gp;
    u32x4 ov;
#pragma unroll
    for (int e = 0; e < 4; ++e) ov[e] = pack2(acc[2 * e] * silu_f(bflo(gv[e])), acc[2 * e + 1] * silu_f(bfhi(gv[e])));
    *(u32x4*)gp = ov;
  }
}

DI void fox_unit(const Params& p, int u, char* smem, bool probe = false) {
  const int tid = otid(), lane = tid & 63, w = __builtin_amdgcn_readfirstlane(tid >> 6), r = lane & 31;
  const int qb = 31 - (u >> 7), bh = u & 127, b = bh >> 4, hd = bh & 15;
  float* c_lds = (float*)(smem + 36864); float* wtot = (float*)(smem + 36864 + 16384);
  __syncthreads();
  {
    const int n = 128 * (qb + 1), s0 = tid * 16;
    float v[16]; float run = 0.f;
#pragma unroll
    for (int q = 0; q < 16; ++q) { float lf = 0.f; if (s0 + q < n) lf = p.logf[((size_t)b * SEQ + s0 + q) * 16 + hd]; run += lf; v[q] = run; }
    float inc = run;
#pragma unroll
    for (int d = 1; d < 64; d <<= 1) { const float t = __shfl_up(inc, d); if (lane >= d) inc += t; }
    if (lane == 63) wtot[w] = inc;
    __syncthreads();
    float off = inc - run;
    for (int q = 0; q < w; ++q) off += wtot[q];
    if (s0 < n) {
#pragma unroll
      for (int q = 0; q < 16; ++q) c_lds[s0 + q] = -(v[q] + off) * 1.4426950408889634f;
    }
    __syncthreads();
  }
  const int tq = 128 * qb + 32 * w + r; const size_t tok = (size_t)b * SEQ + tq;
  bf16x8 qf[4]; load_q(p.Q + tok * 1024 + hd * 64, qf);
  f32x16 o[2]; zero_o(o);
  float m = -1e30f, l = 0.f;
  const ull tiles = tile_range(0, 2 * qb + 1);
  const ull wtiles = tile_range(0, (128 * qb + 32 * w + 31) >> 6);
  flash_loop<1>(smem, p.Kb + (size_t)b * SEQ * 1024 + hd * 64, 1024, p.Vt + (size_t)(b * 16 + hd) * 64 * SEQ, SEQ, tiles, wtiles, qf, o, m, l, tq, 128 * qb + 32 * w, 128 * qb + 32 * w + 31, 0, c_lds, 0ull);
  l += __shfl_xor(l, 32);
  store_gated(o, 1.f / l, p.G, tok, hd);
}

DI void nsa_win_unit(const Params& p, int u, char* smem) {
  const int tid = otid(), lane = tid & 63, w = __builtin_amdgcn_readfirstlane(tid >> 6), r = lane & 31;
  const int chunk = u & 127, hh = (u >> 7) & 1, g = (u >> 8) & 1, b = u >> 9;
  const int q0 = chunk * 32, head = 8 * g + 4 * hh + w, tq = q0 + r; const size_t tok = (size_t)b * SEQ + tq;
  __syncthreads();
  bf16x8 qf[4]; load_q(p.Q + tok * 1024 + head * 64, qf);
  f32x16 o[2]; zero_o(o);
  float m = -1e30f, l = 0.f;
  int lo = (q0 - 255) >> 6; lo = lo < 0 ? 0 : lo; const int hi = (q0 + 31) >> 6;
  const ull tiles = tile_range(lo, hi);
  flash_loop<0>(smem, p.Kb + (size_t)NTOK * 384 + (size_t)b * SEQ * 128 + g * 64, 128, p.Vt + (size_t)NTOK * 128 + (size_t)(b * 2 + g) * 64 * SEQ, SEQ, tiles, tiles, qf, o, m, l, tq, q0, q0 + 31, 255, nullptr, 0ull);
  l += __shfl_xor(l, 32);
  store_plain(o, 1.f / l, p.Q + (size_t)2 * NTOK * 1024 + tok * 1024 + head * 64);
}

DI void nsa_cmp_unit(const Params& p, int u, char* smem) {
  const int tid = otid(), lane = tid & 63, w = __builtin_amdgcn_readfirstlane(tid >> 6), r = lane & 31, h = lane >> 5;
  const int qb = u & 31, g = (u >> 5) & 1, b = u >> 6;
  constexpr int VSTR = 264;
  bf16_t* Kc = (bf16_t*)smem; bf16_t* Vc = (bf16_t*)(smem + 36864);
  __syncthreads();
  {
    const bf16_t* ksrc = p.kcmp + (size_t)(b * 2 + g) * 256 * 64; const bf16_t* vsrc = p.vtcmp + (size_t)(b * 2 + g) * 64 * 256;
#pragma unroll
    for (int q = 0; q < 8; ++q) {
      const int idx = tid + 256 * q;
      *(u32x4*)(Kc + (idx >> 3) * LSTR + (idx & 7) * 8) = *(const u32x4*)(ksrc + (size_t)idx * 8);
      *(u32x4*)(Vc + (idx >> 5) * VSTR + (idx & 31) * 8) = *(const u32x4*)(vsrc + (size_t)idx * 8);
    }
  }
  __syncthreads();
  const int q0 = 128 * qb + 32 * w, tq = q0 + r; const size_t tok = (size_t)b * SEQ + tq;
  const int nc = tq >= 31 ? ((tq - 31) >> 4) + 1 : 0;
  const int ncw = (q0 >> 4) + 1; int ntile = (ncw + 31) >> 5; ntile = ntile > 8 ? 8 : ntile;
  f32x16 imp[2];
#pragma unroll
  for (int jt = 0; jt < 2; ++jt)
#pragma unroll
    for (int i = 0; i < 16; ++i) imp[jt][i] = 0.f;
#pragma unroll 1
  for (int hd = 0; hd < 8; ++hd) {
    const int head = 8 * g + hd;
    bf16x8 qf[4]; load_q(p.Q + tok * 1024 + head * 64, qf);
    float m = -1e30f, l = 0.f;
#pragma unroll 1
    for (int T = 0; T < ntile; ++T) {
      f32x16 s;
#pragma unroll
      for (int i = 0; i < 16; ++i) s[i] = 0.f;
#pragma unroll
      for (int ks = 0; ks < 4; ++ks) s = mfma32(*(const bf16x8*)(Kc + (32 * T + r) * LSTR + 16 * ks + 8 * h), qf[ks], s);
      float mx = -1e30f;
#pragma unroll
      for (int i = 0; i < 16; ++i) { const bool valid = (32 * T + crow(i, h)) < nc; const float v = valid ? s[i] : -1e30f; s[i] = v; mx = fmaxf(mx, v); }
      mx = fmaxf(mx, __shfl_xor(mx, 32));
      const float mn = fmaxf(m, mx); float ps = 0.f;
#pragma unroll
      for (int i = 0; i < 16; ++i) ps += s[i] > -5e29f ? __expf(s[i] - mn) : 0.f;
      l = l * __expf(m - mn) + ps; m = mn;
    }
    l += __shfl_xor(l, 32);
    const float inv = l > 0.f ? 1.f / l : 0.f;
    f32x16 o[2]; zero_o(o);
#pragma unroll 1
    for (int T = 0; T < ntile; ++T) {
      f32x16 s;
#pragma unroll
      for (int i = 0; i < 16; ++i) s[i] = 0.f;
#pragma unroll
      for (int ks = 0; ks < 4; ++ks) s = mfma32(*(const bf16x8*)(Kc + (32 * T + r) * LSTR + 16 * ks + 8 * h), qf[ks], s);
#pragma unroll
      for (int i = 0; i < 16; ++i) { const bool valid = (32 * T + crow(i, h)) < nc; s[i] = valid ? __expf(s[i] - m) * inv : 0.f; }
#pragma unroll
      for (int st = 0; st < 2; ++st) {
        u32x4 ph, pl;
#pragma unroll
        for (int e = 0; e < 4; ++e) {
          const float a0 = s[8 * st + 2 * e], a1 = s[8 * st + 2 * e + 1];
          const unsigned hw = pack2(a0, a1); ph[e] = hw; pl[e] = pack2(a0 - bflo(hw), a1 - bfhi(hw));
        }
        const bf16x8 pbh = __builtin_bit_cast(bf16x8, ph), pbl = __builtin_bit_cast(bf16x8, pl);
#pragma unroll
        for (int dt = 0; dt < 2; ++dt) {
          const s16x4 lo = *(const s16x4*)(Vc + (32 * dt + r) * VSTR + 32 * T + 16 * st + 4 * h);
          const s16x4 hi = *(const s16x4*)(Vc + (32 * dt + r) * VSTR + 32 * T + 16 * st + 8 + 4 * h);
          o[dt] = mfma32(__builtin_shufflevector(lo, hi, 0, 1, 2, 3, 4, 5, 6, 7), pbh, o[dt]);
        }
#pragma unroll
        for (int jt = 0; jt < 2; ++jt) {
          if ((jt == 0 && T <= 3) || (jt == 1 && T >= 3)) {
            const int base = 32 * T + 16 * st + 4 * h - 128 * jt - 4 * r;
            bf16x8 ov;
#pragma unroll
            for (int jj = 0; jj < 8; ++jj) {
              const int d = base + 8 * (jj >> 2) + (jj & 3);
              ov[jj] = (short)((d == -1 || d == 3) ? 0x3F00 : ((d >= 0 && d <= 2) ? 0x3F80 : 0));
            }
            imp[jt] = mfma32(ov, pbh, imp[jt]);
            imp[jt] = mfma32(ov, pbl, imp[jt]);
          }
        }
      }
    }
    store_plain(o, 1.f, p.Q + (size_t)NTOK * 1024 + tok * 1024 + head * 64);
  }
  __syncthreads();
  float* imp_s = (float*)smem;
#pragma unroll
  for (int jt = 0; jt < 2; ++jt)
#pragma unroll
    for (int i = 0; i < 16; ++i) imp_s[(32 * w + r) * 65 + 32 * jt + crow(i, h)] = imp[jt][i];
  __syncthreads();
  if (tid < 128) {
    const int t = 128 * qb + tid, cur = t >> 6;
    ull mask = 1ull | (1ull << cur);
    if (cur >= 2) {
      const int need = (cur - 1) < 6 ? (cur - 1) : 6;
      for (int k = 0; k < need; ++k) {
        int best = 1; float bv = -1.f;
        for (int jj = 1; jj < cur; ++jj) {
          const float v = imp_s[tid * 65 + jj];
          if (!((mask >> jj) & 1ull) && v > bv) { bv = v; best = jj; }
        }
        mask |= 1ull << best;
      }
    }
    p.selmask[(size_t)(b * 2 + g) * SEQ + t] = mask;
  }
}

DI void nsa_slc_unit(const Params& p, int u, char* smem, bool probe = false) {
  const int tid = otid(), lane = tid & 63, w = __builtin_amdgcn_readfirstlane(tid >> 6), r = lane & 31, h = lane >> 5;
  const int chunk = u & 255, g = (u >> 8) & 1, b = u >> 9;
  const int q0 = 16 * chunk, qi = r >> 3, hd = r & 7, tq = q0 + 4 * w + qi, head = 8 * g + hd; const size_t tok = (size_t)b * SEQ + tq;
  __syncthreads();
  const ull* sm = p.selmask + (size_t)(b * 2 + g) * SEQ + q0;
  ull U = 0ull, Wm = 0ull;
#pragma unroll
  for (int i = 0; i < 16; ++i) U |= sm[i];
#pragma unroll
  for (int i = 0; i < 4; ++i) Wm |= sm[4 * w + i];
  const ull lm = sm[4 * w + qi];
  bf16x8 qf[4]; load_q(p.Q + tok * 1024 + head * 64, qf);
  f32x16 o[2]; zero_o(o);
  float m = -1e30f, l = 0.f;
  flash_loop<2>(smem, p.Kb + (size_t)NTOK * 256 + (size_t)b * SEQ * 128 + g * 64, 128, p.Vt + (size_t)(b * 2 + g) * 64 * SEQ, SEQ, U, Wm, qf, o, m, l, tq, q0 + 4 * w, q0 + 4 * w + 3, 0, nullptr, lm);
  l += __shfl_xor(l, 32);
  const float inv = 1.f / l;
  const float g0 = p.gates[tok * 48 + head * 3], g1 = p.gates[tok * 48 + head * 3 + 1] * inv, g2 = p.gates[tok * 48 + head * 3 + 2];
  const bf16_t* oc = p.Q + (size_t)NTOK * 1024 + tok * 1024 + head * 64; const bf16_t* ow = p.Q + (size_t)2 * NTOK * 1024 + tok * 1024 + head * 64;
#pragma unroll
  for (int dt = 0; dt < 2; ++dt)
#pragma unroll
    for (int g4 = 0; g4 < 4; ++g4) {
      const int d = 32 * dt + 8 * g4 + 4 * h;
      bf16_t* gp = p.G + blk(tok, head * 64 + d, NTOK);
      const u32x2 cv = *(const u32x2*)(oc + d), wv = *(const u32x2*)(ow + d), gv = *(const u32x2*)gp;
      const float a0 = (g0 * bflo(cv[0]) + g1 * o[dt][4 * g4] + g2 * bflo(wv[0])) * silu_f(bflo(gv[0]));
      const float a1 = (g0 * bfhi(cv[0]) + g1 * o[dt][4 * g4 + 1] + g2 * bfhi(wv[0])) * silu_f(bfhi(gv[0]));
      const float a2 = (g0 * bflo(cv[1]) + g1 * o[dt][4 * g4 + 2] + g2 * bflo(wv[1])) * silu_f(bflo(gv[1]));
      const float a3 = (g0 * bfhi(cv[1]) + g1 * o[dt][4 * g4 + 3] + g2 * bfhi(wv[1])) * silu_f(bfhi(gv[1]));
      *(u32x2*)gp = (u32x2){pack2(a0, a1), pack2(a2, a3)};
    }
}


DI void naive_swa_phase(const Params& p) {
  const size_t gsz = (size_t)gridDim.x * 256, gid = (size_t)blockIdx.x * 256 + otid();
  for (size_t idx = gid; idx < (size_t)NTOK * 16; idx += gsz) {
    const int head = (int)(idx & 15), kvh = head >> 2; const size_t tok = idx >> 4; const int b = (int)(tok >> 12), tq = (int)(tok & 4095);
    float o[64], m, l;
    naive_core(p.Q + tok * 1024 + head * 64, p.Kb + (size_t)b * SEQ * 256 + kvh * 64, 256, p.Vt + (size_t)(b * 4 + kvh) * 64 * SEQ, SEQ, tq, tq - 127 < 0 ? 0 : tq - 127, 0, nullptr, 0,
               p.sinks[head], 1.f, o, m, l);
    bf16_t* gp = p.G + tok * 1024 + head * 64; const float inv = 1.f / l;
#pragma unroll
    for (int d = 0; d < 64; d += 2) { const unsigned gv = *(const unsigned*)(gp + d); *(unsigned*)(gp + d) = pack2(o[d] * inv * silu_f(bflo(gv)), o[d + 1] * inv * silu_f(bfhi(gv))); }
  }
}
DI void naive_dil_phase(const Params& p) {
  const size_t gsz = (size_t)gridDim.x * 256, gid = (size_t)blockIdx.x * 256 + otid();
  for (size_t idx = gid; idx < (size_t)3 * NTOK * 16; idx += gsz) {
    const int gi = (int)(idx / ((size_t)NTOK * 16)); const size_t rem = idx - (size_t)gi * NTOK * 16;
    const int dlog = 2 * gi, L = SEQ >> dlog;
    const int head = (int)(rem & 15), kvh = head >> 2; const size_t row = rem >> 4; const int bq = (int)(row / L), tq = (int)(row - (size_t)bq * L);
    float o[64], m, l;
    bf16_t* Qg = p.Q + (size_t)gi * NTOK * 1024;
    naive_core(Qg + row * 1024 + head * 64, p.Kb + (size_t)gi * NTOK * 256 + (size_t)bq * L * 256 + kvh * 64, 256, p.Vt + (size_t)gi * NTOK * 256 + (size_t)(bq * 4 + kvh) * 64 * L, L,
               tq, tq - 128 < 0 ? 0 : tq - 128, 0, nullptr, 0, -1e30f, 0.f, o, m, l);
    bf16_t* op = Qg + row * 1024 + head * 64; const float inv = 1.f / l;
#pragma unroll
    for (int d = 0; d < 64; d += 2) *(unsigned*)(op + d) = pack2(o[d] * inv, o[d + 1] * inv);
    p.lse[((size_t)gi * NTOK + row) * 16 + head] = m + __logf(l);
  }
}
DI void naive_win_phase(const Params& p) {
  const size_t gsz = (size_t)gridDim.x * 256, gid = (size_t)blockIdx.x * 256 + otid();
  for (size_t idx = gid; idx < (size_t)NTOK * 16; idx += gsz) {
    const int head = (int)(idx & 15), g = head >> 3; const size_t tok = idx >> 4; const int b = (int)(tok >> 12), tq = (int)(tok & 4095);
    float o[64], m, l;
    naive_core(p.Q + tok * 1024 + head * 64, p.Kb + (size_t)NTOK * 384 + (size_t)b * SEQ * 128 + g * 64, 128, p.Vt + (size_t)NTOK * 128 + (size_t)(b * 2 + g) * 64 * SEQ, SEQ,
               tq, tq - 255 < 0 ? 0 : tq - 255, 0, nullptr, 0, -1e30f, 0.f, o, m, l);
    bf16_t* op = p.Q + (size_t)2 * NTOK * 1024 + tok * 1024 + head * 64; const float inv = 1.f / l;
#pragma unroll
    for (int d = 0; d < 64; d += 2) *(unsigned*)(op + d) = pack2(o[d] * inv, o[d + 1] * inv);
  }
}
DI void naive_fox_phase(const Params& p) {
  const size_t gsz = (size_t)gridDim.x * 256, gid = (size_t)blockIdx.x * 256 + otid();
  for (size_t idx = gid; idx < (size_t)NTOK * 16; idx += gsz) {
    const int head = (int)(idx / NTOK); const size_t tok = idx - (size_t)head * NTOK; const int b = (int)(tok >> 12), tq = (int)(tok & 4095);
    float o[64], m, l;
    naive_core(p.Q + tok * 1024 + head * 64, p.Kb + (size_t)b * SEQ * 1024 + head * 64, 1024, p.Vt + (size_t)(b * 16 + head) * 64 * SEQ, SEQ,
               tq, 0, 1, p.logf + (size_t)b * SEQ * 16 + head, 16, -1e30f, 0.f, o, m, l);
    bf16_t* gp = p.G + tok * 1024 + head * 64; const float inv = 1.f / l;
#pragma unroll
    for (int d = 0; d < 64; d += 2) { const unsigned gv = *(const unsigned*)(gp + d); *(unsigned*)(gp + d) = pack2(o[d] * inv * silu_f(bflo(gv)), o[d + 1] * inv * silu_f(bfhi(gv))); }
  }
}

DI void final_norm_phase(const Params& p) {
  const int tid = otid(), lane = tid & 63; const int wv = blockIdx.x * 4 + (tid >> 6), nw = gridDim.x * 4;
  for (int t = wv; t < NTOK; t += nw) {
    const bf16_t* src = p.xb + blk(t, lane * 16, NTOK);
    const u32x4 a = *(const u32x4*)src, b = *(const u32x4*)(src + 8);
    float v[16]; float ss = 0.f;
#pragma unroll
    for (int e = 0; e < 4; ++e) { v[2 * e] = bflo(a[e]); v[2 * e + 1] = bfhi(a[e]); v[8 + 2 * e] = bflo(b[e]); v[8 + 2 * e + 1] = bfhi(b[e]); }
#pragma unroll
    for (int i = 0; i < 16; ++i) ss += v[i] * v[i];
#pragma unroll
    for (int d = 1; d < 64; d <<= 1) ss += __shfl_xor(ss, d);
    const float rs = rsqrtf(ss * (1.f / 1024.f) + 1e-6f);
    float* row = p.out + (size_t)t * 1024 + lane * 16;
#pragma unroll
    for (int i = 0; i < 4; ++i) {
      const f32x4 gn = *(const f32x4*)(p.final_norm + lane * 16 + 4 * i);
      f32x4 o; o[0] = v[4 * i] * rs * gn[0]; o[1] = v[4 * i + 1] * rs * gn[1]; o[2] = v[4 * i + 2] * rs * gn[2]; o[3] = v[4 * i + 3] * rs * gn[3];
      *(f32x4*)(row + 4 * i) = o;
    }
  }
}


DI void gbar(unsigned* bar, unsigned k) {
  asm volatile("s_waitcnt vmcnt(0)" ::: "memory");
  __syncthreads();
  if (threadIdx.x == 0) {
    const unsigned G = gridDim.x, grp = blockIdx.x & 7u, ng = (G + 7u - grp) >> 3, ngroups = G < 8u ? G : 8u;
    __builtin_amdgcn_fence(__ATOMIC_RELEASE, "agent");
    asm volatile("s_waitcnt vmcnt(0)" ::: "memory");
    const unsigned old = __hip_atomic_fetch_add(bar + 64 * grp, 1u, __ATOMIC_RELAXED, __HIP_MEMORY_SCOPE_AGENT);
    if (old + 1u == ng * k) {
      const unsigned o2 = __hip_atomic_fetch_add(bar + 64 * 8, 1u, __ATOMIC_RELAXED, __HIP_MEMORY_SCOPE_AGENT);
      if (o2 + 1u == ngroups * k) {
        for (unsigned g = 0; g < 8u; ++g) __hip_atomic_store(bar + 64 * (9 + g), k, __ATOMIC_RELAXED, __HIP_MEMORY_SCOPE_AGENT);
      }
    }
    while (__hip_atomic_load(bar + 64 * (9 + grp), __ATOMIC_RELAXED, __HIP_MEMORY_SCOPE_AGENT) < k) __builtin_amdgcn_s_sleep(1);
    __builtin_amdgcn_fence(__ATOMIC_ACQUIRE, "agent");
    asm volatile("s_waitcnt vmcnt(0)" ::: "memory");
  }
  __syncthreads();
}

DI int balance_unit(int u, int G) {
  const int k = u / G, i = u - k * G;
  return (k & 1) ? (k * G + (G - 1 - i)) : u;
}


__global__ void __launch_bounds__(256, 2) mega_kernel(Params p) {
  extern __shared__ __attribute__((aligned(16))) char smem[];
  cg::grid_group grid = cg::this_grid();
  const int G = gridDim.x;
  unsigned bk = 0;
  if (blockIdx.x == 0 && threadIdx.x < 17) __hip_atomic_store(p.bar + 64 * threadIdx.x, 0u, __ATOMIC_RELAXED, __HIP_MEMORY_SCOPE_AGENT);
#if PROBE_PREP
  prep_phase(p, smem);
#endif
  prep_phase(p, smem);
  grid.sync();
#pragma unroll 1
  for (int layer = 0; layer < 4; ++layer) {
    if (layer == 0 && blockIdx.x == G - 1) {
      for (int n = otid(); n < 512; n += 256) {
        float a = 0.f; const int kv = n >> 8, c = n & 255;
        for (int ch = 0; ch < 32; ++ch) a += p.cbp[(kv * 32 + ch) * 256 + c];
        p.cb[n] = a;
      }
    }
    {
      GemmJob j; j.ablk = 0; j.bblk = 0; j.A = p.xb; j.Bt = p.wt_in[layer]; j.lda = 1024; j.K = 1024; j.amode = 0; j.epi = E_SEG; j.layer = layer; j.kv = 0; j.res = nullptr; j.ablk = NTOK; j.bblk = p.npad[layer];
      gemm_phase(p, j, 128, p.npad[layer] >> 7, smem);
    }
    gbar(p.bar, ++bk);
    if (layer == 0) {
#if DBG_SWA
      naive_swa_phase(p);
#else
#if PROBE_SWA
      for (int u = blockIdx.x; u < 4096; u += G) swa_unit(p, u, smem, true);
#endif
      for (int u = blockIdx.x; u < 4096; u += G) swa_unit(p, u, smem);
#endif
    } else if (layer == 1) {
#if DBG_DIL
      naive_dil_phase(p);
#else
#if PROBE_DIL
      for (int u = blockIdx.x; u < 3 * 4096; u += G) { const int gi = u >> 12; dil_unit(p, gi, 2 * gi, u & 4095, smem, true); }
#endif
      for (int u = blockIdx.x; u < 3 * 4096; u += G) { const int gi = u >> 12; dil_unit(p, gi, 2 * gi, u & 4095, smem); }
#endif
      gbar(p.bar, ++bk);
#if PROBE_MERGE
      dil_merge_phase(p, true);
#endif
      dil_merge_phase(p);
    } else if (layer == 2) {
#if DBG_FOX
      naive_fox_phase(p);
#else
#if PROBE_FOX
      for (int u = blockIdx.x; u < 4096; u += G) fox_unit(p, balance_unit(u, G), smem, true);
#endif
      for (int u = blockIdx.x; u < 4096; u += G) fox_unit(p, balance_unit(u, G), smem);
#endif
    } else {
      for (int e = blockIdx.x; e < 64; e += G) {
        const int kv = e >> 5;
        GemmJob j; j.ablk = 0; j.bblk = 0; j.A = p.Kb + kv * 128; j.Bt = p.wt_c1[kv]; j.lda = 256; j.K = 2048; j.amode = 1; j.epi = E_GELU; j.layer = 3; j.kv = kv; j.res = nullptr;
        gemm_tile(p, j, (e >> 1) & 15, e & 1, smem);
      }
#if DBG_WIN
      naive_win_phase(p);
#else
#if PROBE_WIN
      for (int u = blockIdx.x; u < 2048; u += G) nsa_win_unit(p, u, smem);
      if (G == 512) { if (blockIdx.x >= 64) for (int u = blockIdx.x - 64; u < 2048; u += 448) nsa_win_unit(p, u, smem); }
      else for (int u = blockIdx.x; u < 2048; u += G) nsa_win_unit(p, u, smem);
#endif
      if (G == 512) { if (blockIdx.x >= 64) for (int u = blockIdx.x - 64; u < 2048; u += 448) nsa_win_unit(p, u, smem); }
      else for (int u = blockIdx.x; u < 2048; u += G) nsa_win_unit(p, u, smem);
#endif
      gbar(p.bar, ++bk);
      for (int e = blockIdx.x; e < 32; e += G) {
        const int kv = e >> 4;
        GemmJob j; j.ablk = 0; j.bblk = 0; j.A = p.hid + (size_t)kv * 4096 * 256; j.Bt = p.wt_c2[kv]; j.lda = 256; j.K = 256; j.amode = 0; j.epi = E_CMP2; j.layer = 3; j.kv = kv; j.res = nullptr;
        gemm_tile(p, j, e & 15, 0, smem);
      }
#if !DBG_WIN
      if (G != 512) for (int u = 2048 + blockIdx.x; u < 4096; u += G) nsa_win_unit(p, u, smem);
#endif
      gbar(p.bar, ++bk);
#if PROBE_CMP
      for (int u = blockIdx.x; u < 512; u += G) nsa_cmp_unit(p, u, smem);
#endif
      for (int u = blockIdx.x; u < 512; u += G) nsa_cmp_unit(p, u, smem);
      if (G == 512) {
        const int qb = blockIdx.x & 31, grp = blockIdx.x >> 5;
        int c0 = 0;
        for (int q = 0; q < qb; ++q) c0 += ((31 - q) * 8 + 15) / 31;
        const int n = ((31 - qb) * 8 + 15) / 31;
        for (int k = 0; k < n; ++k) nsa_win_unit(p, 2048 + grp * 128 + c0 + k, smem);
      }
      gbar(p.bar, ++bk);
#if PROBE_SLC
      for (int u = blockIdx.x; u < 4096; u += G) nsa_slc_unit(p, u, smem, true);
#endif
      for (int u = blockIdx.x; u < 4096; u += G) {
        const int v = balance_unit(u, G), ch = 255 - (v >> 4), gb = v & 15;
        nsa_slc_unit(p, ((gb >> 1) << 9) | ((gb & 1) << 8) | ch, smem);
      }
    }
    gbar(p.bar, ++bk);
    {
      GemmJob j; j.ablk = 0; j.bblk = 0; j.A = p.G; j.Bt = p.wt_out[layer]; j.lda = 1024; j.K = 1024; j.amode = 0; j.epi = E_OUT; j.layer = layer; j.kv = 0; j.res = (layer == 0) ? p.x : (const float*)nullptr; j.outp = p.out; j.xbp = p.xb; j.ssq_out = p.ssqp; j.ablk = NTOK; j.bblk = 1024;
#if PROBE_GOUT
      { GemmJob j2 = j; j2.outp = (float*)p.Q; j2.xbp = p.Kb; j2.ssq_out = nullptr; gemm_phase(p, j2, 128, 8, smem); }
#endif
      gemm_phase(p, j, 128, 8, smem);
    }
    gbar(p.bar, ++bk);
  }
  final_norm_phase(p);
}

static void add_seg(Params& p, int layer, int nb, int kind, void* dst, int ld, int dlog, int nkv, float scale) {
  Seg& s = p.segs[layer][p.nseg[layer]++];
  s.dst = dst; s.nb = nb; s.kind = kind; s.dlog = dlog; s.ld = ld; s.nkv = nkv; s.scale = scale;
}

extern "C" void kernel_launch(void* const* d_in, const int* in_sizes, int n_in, void* d_out, int out_size, void* d_ws, size_t ws_size, hipStream_t stream) {
  constexpr size_t MiB = 1u << 20;
  constexpr size_t OFF_WIN = 0, OFF_WOUT = 31457280, OFF_WC1 = 39845888, OFF_WC2 = 41943040, OFF_CBP = 42074112, OFF_CB = 42139648;
  constexpr size_t OFF_ROPE = 42 * MiB, OFF_XB = 44 * MiB, OFF_Q = 108 * MiB, OFF_K = 300 * MiB, OFF_VT = 364 * MiB, OFF_G = 428 * MiB, OFF_SM = 492 * MiB, WS_END = 504 * MiB;
  static int grid_blocks = 0;
  if (grid_blocks == 0) {
    if (n_in != 23 || ws_size < WS_END) { fprintf(stderr, "kernel_launch: unexpected n_in %d or ws_size %zu (need %zu)\n", n_in, ws_size, (size_t)WS_END); grid_blocks = -1; return; }
    int dev = 0, cus = 0, per_cu = 0;
    hipGetDevice(&dev);
    hipDeviceGetAttribute(&cus, hipDeviceAttributeMultiprocessorCount, dev);
    if (hipFuncSetAttribute((const void*)mega_kernel, hipFuncAttributeMaxDynamicSharedMemorySize, LDS_BYTES) != hipSuccess) { fprintf(stderr, "hipFuncSetAttribute failed\n"); grid_blocks = -1; return; }
    if (hipOccupancyMaxActiveBlocksPerMultiprocessor(&per_cu, (const void*)mega_kernel, 256, LDS_BYTES) != hipSuccess || per_cu < 1) { fprintf(stderr, "occupancy query failed (%d)\n", per_cu); (void)hipGetLastError(); grid_blocks = -1; return; }
    if (per_cu > 2) per_cu = 2;
    grid_blocks = cus * per_cu;
    fprintf(stderr, "kernel_launch: cus %d per_cu %d grid %d\n", cus, per_cu, grid_blocks);
  }
  if (grid_blocks < 0) return;
  char* ws = (char*)d_ws;
  Params p;
  memset(&p, 0, sizeof(p));
  const float* const* in = (const float* const*)d_in;
  p.x = in[0]; p.pos = (const int*)d_in[1];
  const float* norm[4] = {in[2], in[6], in[9], in[13]};
  const float* w_in[4] = {in[3], in[7], in[10], in[14]};
  p.sinks = in[4]; p.b_f = in[11];
  p.w_out[0] = in[5]; p.w_out[1] = in[8]; p.w_out[2] = in[12]; p.w_out[3] = in[21];
  p.pe[0] = in[15]; p.w1[0] = in[16]; const float* w2k = in[17];
  p.pe[1] = in[18]; p.w1[1] = in[19]; const float* w2v = in[20];
  p.final_norm = in[22];
  p.out = (float*)d_out;
  const int nsrc[4] = {2560, 5632, 4112, 2864}; const int npad[4] = {2560, 5632, 4224, 2944}; const int maps[4] = {0, 0, 2, 3};
  size_t wo = 0;
  for (int l = 0; l < 4; ++l) { p.wt_in[l] = (bf16_t*)(ws + OFF_WIN) + wo; wo += (size_t)npad[l] * 1024; p.wt_out[l] = (bf16_t*)(ws + OFF_WOUT) + (size_t)l * 1024 * 1024; p.npad[l] = npad[l]; }
  for (int kv = 0; kv < 2; ++kv) { p.wt_c1[kv] = (bf16_t*)(ws + OFF_WC1) + (size_t)kv * 256 * 2048; p.wt_c2[kv] = (bf16_t*)(ws + OFF_WC2) + (size_t)kv * 128 * 256; }
  p.cbp = (float*)(ws + OFF_CBP); p.cb = (float*)(ws + OFF_CB); p.bar = (unsigned*)(ws + 41 * MiB + 768 * 1024); p.ssqp = (float*)(ws + 40 * MiB + 512 * 1024);
  p.rope = (f32x2*)(ws + OFF_ROPE); p.xb = (bf16_t*)(ws + OFF_XB); p.Q = (bf16_t*)(ws + OFF_Q); p.Kb = (bf16_t*)(ws + OFF_K); p.Vt = (bf16_t*)(ws + OFF_VT); p.G = (bf16_t*)(ws + OFF_G);
  p.lse = (float*)(ws + OFF_SM); p.logf = (float*)(ws + OFF_SM); p.gates = (float*)(ws + OFF_SM);
  p.selmask = (ull*)(ws + OFF_SM + 6 * MiB); p.hid = (bf16_t*)(ws + OFF_SM + 7 * MiB); p.kcmp = (bf16_t*)(ws + OFF_SM + 11 * MiB); p.vtcmp = (bf16_t*)(ws + OFF_SM + 11 * MiB + 512 * 1024);
  int nt = 0, tiles = 0;
  auto add_tj = [&](const float* src, bf16_t* dst, const float* gain, int ksrc, int ns, int nd, int map) {
    TJob& t = p.tj[nt++]; t.src = src; t.dst = dst; t.gain = gain; t.ksrc = ksrc; t.nsrc = ns; t.ndst = nd; t.map = map; t.tile0 = tiles; t.blk = (ksrc == 1024) ? 1 : 0;
    tiles += (nd / 64) * (ksrc / 64);
  };
  for (int l = 0; l < 4; ++l) add_tj(w_in[l], p.wt_in[l], norm[l], 1024, nsrc[l], npad[l], maps[l]);
  for (int l = 0; l < 4; ++l) add_tj(p.w_out[l], p.wt_out[l], nullptr, 1024, 1024, 1024, 0);
  add_tj(p.w1[0], p.wt_c1[0], nullptr, 2048, 256, 256, 0);
  add_tj(p.w1[1], p.wt_c1[1], nullptr, 2048, 256, 256, 0);
  add_tj(w2k, p.wt_c2[0], nullptr, 256, 64, 128, 0);
  add_tj(w2v, p.wt_c2[1], nullptr, 256, 64, 128, 0);
  p.ntj = nt; p.ttiles = tiles;
  for (int i = 0; i < 8; ++i) p.inv_freq[i] = (float)pow(500000.0, -(double)i / 8.0);
  const size_t NT = (size_t)NTOK;
  add_seg(p, 0, 0, K_ROPE, p.Q, 1024, 0, 0, 0.125f);
  add_seg(p, 0, 1024, K_ROPE, p.Kb, 256, 0, 0, 1.f);
  add_seg(p, 0, 1280, K_VT, p.Vt, 0, 0, 4, 1.f);
  add_seg(p, 0, 1536, K_PLAINB, p.G, 1024, 0, 0, 1.f);
  for (int gi = 0; gi < 3; ++gi) {
    add_seg(p, 1, 1536 * gi, K_ROPE, p.Q + gi * NT * 1024, 1024, 2 * gi, 0, 0.125f);
    add_seg(p, 1, 1536 * gi + 1024, K_ROPE, p.Kb + gi * NT * 256, 256, 2 * gi, 0, 1.f);
    add_seg(p, 1, 1536 * gi + 1280, K_VT, p.Vt + gi * NT * 256, 0, 2 * gi, 4, 1.f);
  }
  add_seg(p, 1, 4608, K_PLAINB, p.G, 1024, 0, 0, 1.f);
  add_seg(p, 2, 0, K_PLAIN, p.Q, 1024, 0, 0, 0.125f);
  add_seg(p, 2, 1024, K_PLAIN, p.Kb, 1024, 0, 0, 1.f);
  add_seg(p, 2, 2048, K_VT, p.Vt, 0, 0, 16, 1.f);
  add_seg(p, 2, 3072, K_PLAINB, p.G, 1024, 0, 0, 1.f);
  add_seg(p, 2, 4096, K_FLOG, nullptr, 0, 0, 0, 1.f);
  add_seg(p, 2, 4160, K_NONE, nullptr, 0, 0, 0, 1.f);
  add_seg(p, 3, 0, K_ROPE, p.Q, 1024, 0, 0, 0.125f);
  add_seg(p, 3, 1024, K_PLAIN, p.Kb, 256, 0, 0, 1.f);
  add_seg(p, 3, 1152, K_PLAIN, p.Kb + 128, 256, 0, 0, 1.f);
  add_seg(p, 3, 1280, K_ROPE, p.Kb + NT * 256, 128, 0, 0, 1.f);
  add_seg(p, 3, 1408, K_VT, p.Vt, 0, 0, 2, 1.f);
  add_seg(p, 3, 1536, K_ROPE, p.Kb + NT * 384, 128, 0, 0, 1.f);
  add_seg(p, 3, 1664, K_VT, p.Vt + NT * 128, 0, 0, 2, 1.f);
  add_seg(p, 3, 1792, K_PLAINB, p.G, 1024, 0, 0, 1.f);
  add_seg(p, 3, 2816, K_GLOG, nullptr, 0, 0, 0, 1.f);
  add_seg(p, 3, 2880, K_NONE, nullptr, 0, 0, 0, 1.f);
  void* args[] = {&p};
  hipError_t e = hipLaunchCooperativeKernel((const void*)mega_kernel, dim3(grid_blocks), dim3(256), args, LDS_BYTES, stream);
  if (e != hipSuccess) fprintf(stderr, "cooperative launch failed: %s (grid %d)\n", hipGetErrorString(e), grid_blocks);
}
```

```cpp
#include <hip/hip_runtime.h>
#include <hip/hip_cooperative_groups.h>
#include <cstdint>
#include <cstdio>
#include <cmath>
#include <cstring>
namespace cg = cooperative_groups;
#define DBG_SWA 0
#define DBG_DIL 0
#define DBG_WIN 0
#define DBG_FOX 0
#define PROBE_SWA 0
#define PROBE_DIL 0
#define PROBE_MERGE 0
#define PROBE_FOX 0
#define PROBE_CMP 0
#define PROBE_SLC 0
#define PROBE_WIN 0
#define PROBE_GOUT 0
#define PROBE_PREP 0

#define DI __device__ __forceinline__
typedef unsigned short bf16_t;
typedef unsigned long long ull;
typedef short bf16x8 __attribute__((ext_vector_type(8)));
typedef short s16x4 __attribute__((ext_vector_type(4)));
typedef float f32x16 __attribute__((ext_vector_type(16)));
typedef float f32x4 __attribute__((ext_vector_type(4)));
typedef float f32x2 __attribute__((ext_vector_type(2)));
typedef unsigned u32x4 __attribute__((ext_vector_type(4)));
typedef unsigned u32x2 __attribute__((ext_vector_type(2)));
typedef __bf16 bf16x2_t __attribute__((ext_vector_type(2)));

constexpr int SEQ = 4096, NTOK = 8 * 4096;
constexpr int LDS_BYTES = 76800;
constexpr int LSTR = 72;

enum { K_NONE = 0, K_PLAIN, K_ROPE, K_VT, K_FLOG, K_GLOG, K_PLAINB };
enum { E_SEG = 0, E_OUT, E_GELU, E_CMP2 };

struct Seg { void* dst; int nb; int kind; int dlog; int ld; int nkv; float scale; };
struct TJob { const float* src; bf16_t* dst; const float* gain; int ksrc; int nsrc; int ndst; int map; int tile0; int blk; };

struct Params {
  const float* x; const int* pos;
  const float* w_out[4];
  const float* sinks; const float* b_f;
  const float* pe[2]; const float* w1[2];
  const float* final_norm;
  float* out;
  bf16_t* wt_in[4]; bf16_t* wt_out[4]; bf16_t* wt_c1[2]; bf16_t* wt_c2[2];
  float* cbp; float* cb; unsigned* bar; float* ssqp;
  f32x2* rope; bf16_t* xb; bf16_t* Q; bf16_t* Kb; bf16_t* Vt; bf16_t* G;
  float* lse; float* logf; float* gates; ull* selmask; bf16_t* hid; bf16_t* kcmp; bf16_t* vtcmp;
  Seg segs[4][12];
  TJob tj[12];
  int nseg[4]; int npad[4];
  int ntj; int ttiles;
  float inv_freq[8];
};

DI unsigned pack2(float a, float b) { f32x2 v = {a, b}; bf16x2_t r = __builtin_convertvector(v, bf16x2_t); return __builtin_bit_cast(unsigned, r); }
DI bf16_t f2bf(float a) { return (bf16_t)(pack2(a, 0.f) & 0xffffu); }
DI float bflo(unsigned v) { return __uint_as_float(v << 16); }
DI float bfhi(unsigned v) { return __uint_as_float(v & 0xffff0000u); }
DI f32x16 mfma32(bf16x8 a, bf16x8 b, f32x16 c) { return __builtin_amdgcn_mfma_f32_32x32x16_bf16(a, b, c, 0, 0, 0); }
DI int otid() { int t = threadIdx.x; asm volatile("" : "+v"(t)); return t; }
DI size_t blk(size_t row, int k, int R) { return ((size_t)(k >> 5) * R + row) * 32 + (k & 31); }
DI int crow(int i, int h) { return (i & 3) + 8 * (i >> 2) + 4 * h; }
DI float silu_f(float x) { return x / (1.f + __expf(-x)); }
DI float sigmoid_f(float x) { return 1.f / (1.f + __expf(-x)); }
DI float gelu_tanh(float x) { float y = 0.7978845608028654f * (x + 0.044715f * x * x * x); float e = __expf(2.f * y); float th = 1.f - 2.f / (e + 1.f); return 0.5f * x * (1.f + th); }
DI float logsigmoid_f(float z) { return fminf(z, 0.f) - __logf(1.f + __expf(-fabsf(z))); }

DI int srcmap(int map, int n, int nsrc) {
  if (map == 2) {
    if (n < 3072) return n; if (n < 4096) return n + 16; if (n < 4112) return n - 1024; return -1;
  }
  if (map == 3) {
    if (n < 1792) return n; if (n < 2816) return n + 48; if (n < 2864) return n - 1024; return -1;
  }
  return n < nsrc ? n : -1;
}

DI void prep_phase(const Params& p, char* smem) {
  const int tid = otid();
  float* tl = (float*)smem;
  for (int u = blockIdx.x; u < p.ttiles; u += gridDim.x) {
    int ji = 0;
    for (int q = 1; q < p.ntj; ++q) if (u >= p.tj[q].tile0) ji = q;
    const TJob j = p.tj[ji];
    const int tile = u - j.tile0; const int nnt = j.ndst >> 6; const int nt = tile % nnt, kt = tile / nnt;
    const int n0 = nt * 64, k0 = kt * 64;
    __syncthreads();
    {
      const int nn = (tid & 15) * 4; const int sc = srcmap(j.map, n0 + nn, j.nsrc);
      f32x4 v[4];
#pragma unroll
      for (int i = 0; i < 4; ++i) {
        const int kk = (tid >> 4) + 16 * i;
        v[i] = (f32x4){0.f, 0.f, 0.f, 0.f};
        if (sc >= 0) v[i] = *(const f32x4*)(j.src + (size_t)(k0 + kk) * j.nsrc + sc);
      }
#pragma unroll
      for (int i = 0; i < 4; ++i) {
        const int kk = (tid >> 4) + 16 * i;
        const float gn = j.gain ? j.gain[k0 + kk] : 1.f;
        tl[kk * 65 + nn] = v[i][0] * gn; tl[kk * 65 + nn + 1] = v[i][1] * gn; tl[kk * 65 + nn + 2] = v[i][2] * gn; tl[kk * 65 + nn + 3] = v[i][3] * gn;
      }
    }
    __syncthreads();
    {
      const int nn = tid >> 2, kc = (tid & 3) * 16;
      unsigned w[8];
#pragma unroll
      for (int q = 0; q < 8; ++q) w[q] = pack2(tl[(kc + 2 * q) * 65 + nn], tl[(kc + 2 * q + 1) * 65 + nn]);
      bf16_t* d = j.blk ? j.dst + blk(n0 + nn, k0 + kc, j.ndst) : j.dst + (size_t)(n0 + nn) * j.ksrc + k0 + kc;
      *(u32x4*)d = (u32x4){w[0], w[1], w[2], w[3]};
      *(u32x4*)(d + 8) = (u32x4){w[4], w[5], w[6], w[7]};
    }
  }
  for (int u = blockIdx.x; u < 64; u += gridDim.x) {
    const int kv = u >> 5, ch = u & 31; const float* pe = p.pe[kv]; const float* w1 = p.w1[kv];
    float acc = 0.f;
    for (int rr = 0; rr < 64; ++rr) { const int row = ch * 64 + rr; acc += pe[row] * w1[(size_t)row * 256 + tid]; }
    p.cbp[(kv * 32 + ch) * 256 + tid] = acc;
  }
  const size_t gsz = (size_t)gridDim.x * 256, gid = (size_t)blockIdx.x * 256 + tid;
  {
    const int lane = tid & 63; const int wv = blockIdx.x * 4 + (tid >> 6), nw = gridDim.x * 4;
    for (int t = wv; t < NTOK; t += nw) {
      float ss = 0.f;
#pragma unroll
      for (int hf = 0; hf < 2; ++hf) {
        const size_t off = (size_t)t * 1024 + hf * 512 + lane * 8;
        const f32x4 a = *(const f32x4*)(p.x + off), b = *(const f32x4*)(p.x + off + 4);
        *(u32x4*)(p.xb + blk(t, hf * 512 + lane * 8, NTOK)) = (u32x4){pack2(a[0], a[1]), pack2(a[2], a[3]), pack2(b[0], b[1]), pack2(b[2], b[3])};
        ss += a[0] * a[0] + a[1] * a[1] + a[2] * a[2] + a[3] * a[3] + b[0] * b[0] + b[1] * b[1] + b[2] * b[2] + b[3] * b[3];
      }
#pragma unroll
      for (int d = 1; d < 64; d <<= 1) ss += __shfl_xor(ss, d);
      if (lane < 8) p.ssqp[(size_t)t * 8 + lane] = lane == 0 ? ss : 0.f;
    }
  }
  for (size_t i = gid; i < (size_t)NTOK * 8; i += gsz) {
    const int t = (int)(i >> 3), k = (int)(i & 7);
    const float ang = (float)p.pos[t] * p.inv_freq[k];
    double rv = (double)ang * 0.15915494309189535; rv -= floor(rv);
    const float rf = (float)rv;
    p.rope[i] = (f32x2){__builtin_amdgcn_cosf(rf), __builtin_amdgcn_sinf(rf)};
  }
}

struct GemmJob {
  const bf16_t* A; const bf16_t* Bt; int lda; int K; int amode; int epi; int layer; int kv;
  const float* res; float* outp; bf16_t* xbp; float* ssq_out; int ablk; int bblk;
};

DI unsigned a_rowoff(const GemmJob& j, int row) {
  if (j.amode == 0) return (unsigned)row * (unsigned)j.lda;
  row = row < 4080 ? row : 4079;
  const int g = row & 1, bi = row >> 1, b = bi / 255, i = bi - b * 255;
  return (unsigned)(b * SEQ + 16 * i) * (unsigned)j.lda + g * 64;
}

constexpr int GSTAGE = 24576;
constexpr int RSTD_OFF = 73728;
#define RAW_BARRIER() do { asm volatile("s_waitcnt lgkmcnt(0)" ::: "memory"); __builtin_amdgcn_s_barrier(); } while (0)
typedef __attribute__((address_space(1))) const void* gptr_t;
typedef __attribute__((address_space(3))) void* lptr_t;

DI void gemm_tile(const Params& p, const GemmJob& j, int mt, int nt, char* smem) {
  const int tid = otid(), lane = tid & 63, wid = __builtin_amdgcn_readfirstlane(tid >> 6), r = lane & 31, h = lane >> 5;
  const int wn = wid & 1, wt = wid >> 1;
  float* rstd_s = (float*)(smem + RSTD_OFF);
  const int t0 = mt * 256, n0 = nt * 128;
  const int rl = lane >> 2, c8s = ((lane & 3) ^ ((lane >> 4) & 3)) * 8;
  const int nk = j.K >> 5;
  f32x16 acc[2][4];
#pragma unroll
  for (int a = 0; a < 2; ++a)
#pragma unroll
    for (int b = 0; b < 4; ++b)
#pragma unroll
      for (int i = 0; i < 16; ++i) acc[a][b][i] = 0.f;
  auto glds = [&](int kt, int stage) {
    char* sb = smem + stage * GSTAGE;
    const unsigned ko = j.amode ? (unsigned)((kt >> 1) * j.lda + (kt & 1) * 32) : (unsigned)(kt * 32);
#pragma unroll
    for (int q = 0; q < 2; ++q) {
      const int ch = q * 4 + wid;
      const bf16_t* src = j.bblk ? j.Bt + ((size_t)kt * j.bblk + n0 + 16 * ch + rl) * 32 + c8s : j.Bt + (size_t)(n0 + 16 * ch + rl) * j.K + kt * 32 + c8s;
      __builtin_amdgcn_global_load_lds((gptr_t)src, (lptr_t)(sb + ch * 1024), 16, 0, 0);
    }
#pragma unroll
    for (int q = 0; q < 4; ++q) {
      const int ch = q * 4 + wid;
      const bf16_t* src = j.ablk ? j.A + ((size_t)kt * j.ablk + t0 + 16 * ch + rl) * 32 + c8s : j.A + a_rowoff(j, t0 + 16 * ch + rl) + ko + c8s;
      __builtin_amdgcn_global_load_lds((gptr_t)src, (lptr_t)(sb + 8192 + ch * 1024), 16, 0, 0);
    }
  };
  const int fr = (r >> 2) & 3; const int o0 = (h ^ fr) * 16;
  __syncthreads();
  glds(0, 0);
  if (nk > 1) glds(1, 1);
  int st = 0, st2 = 2;
  for (int kt = 0; kt < nk; ++kt) {
    if (kt + 1 < nk) asm volatile("s_waitcnt vmcnt(6)" ::: "memory"); else asm volatile("s_waitcnt vmcnt(0)" ::: "memory");
    RAW_BARRIER();
    if (kt + 2 < nk) glds(kt + 2, st2);
    const char* sb = smem + st * GSTAGE;
#pragma unroll
    for (int ks = 0; ks < 2; ++ks) {
      const int off = ks ? (o0 ^ 32) : o0;
      bf16x8 wf[2], xf[4];
#pragma unroll
      for (int a = 0; a < 2; ++a) wf[a] = *(const bf16x8*)(sb + (64 * wn + 32 * a + r) * 64 + off);
#pragma unroll
      for (int b = 0; b < 4; ++b) xf[b] = *(const bf16x8*)(sb + 8192 + (128 * wt + 32 * b + r) * 64 + off);
#pragma unroll
      for (int a = 0; a < 2; ++a)
#pragma unroll
        for (int b = 0; b < 4; ++b) acc[a][b] = mfma32(wf[a], xf[b], acc[a][b]);
    }
    st = (st == 2) ? 0 : st + 1; st2 = (st2 == 2) ? 0 : st2 + 1;
  }
  __syncthreads();
  if (j.epi == E_SEG) {
    const float* sp = p.ssqp + (size_t)(t0 + tid) * 8;
    const f32x4 s0 = *(const f32x4*)sp, s1 = *(const f32x4*)(sp + 4);
    rstd_s[tid] = rsqrtf(((s0[0] + s0[1]) + (s0[2] + s0[3]) + (s1[0] + s1[1]) + (s1[2] + s1[3])) * (1.f / 1024.f) + 1e-6f);
    __syncthreads();
  }
  const int cb = n0 + 64 * wn;
  if (j.epi == E_SEG) {
    const Seg* sg = p.segs[j.layer]; const int nsg = p.nseg[j.layer];
    {
      int si = 0;
      for (int q = 1; q < nsg; ++q) if (cb >= sg[q].nb) si = q;
      const Seg s = sg[si]; const int hd = (cb - s.nb) >> 6;
      bf16_t* Ch = (bf16_t*)smem + wn * (256 * LSTR);
#pragma unroll
      for (int ni = 0; ni < 4; ++ni) {
        const int tl = 128 * wt + 32 * ni + r, t = t0 + tl; const float rs = rstd_s[tl];
#pragma unroll
        for (int mi = 0; mi < 2; ++mi) {
          float v[16];
#pragma unroll
          for (int i = 0; i < 16; ++i) v[i] = acc[mi][ni][i] * rs;
          if (s.kind == K_ROPE && mi == 0) {
#pragma unroll
            for (int i = 0; i < 4; ++i) {
              const f32x2 cs = p.rope[(size_t)t * 8 + 4 * h + i]; const float x1 = v[i], x2 = v[i + 4];
              v[i] = x1 * cs[0] - x2 * cs[1]; v[i + 4] = x2 * cs[0] + x1 * cs[1];
            }
          }
          if (s.kind == K_PLAIN || s.kind == K_ROPE || s.kind == K_PLAINB) {
#pragma unroll
            for (int g = 0; g < 4; ++g)
              *(u32x2*)(Ch + tl * LSTR + 32 * mi + 8 * g + 4 * h) = (u32x2){pack2(v[4 * g] * s.scale, v[4 * g + 1] * s.scale), pack2(v[4 * g + 2] * s.scale, v[4 * g + 3] * s.scale)};
          } else if (s.kind == K_VT) {
#pragma unroll
            for (int i = 0; i < 16; ++i) Ch[(32 * mi + crow(i, h)) * 264 + tl] = f2bf(v[i]);
          } else if (s.kind == K_FLOG) {
#pragma unroll
            for (int i = 0; i < 8; ++i) { const int hh = crow(i, h); if (hd == 0 && mi == 0) p.logf[(size_t)t * 16 + hh] = logsigmoid_f(v[i] + p.b_f[hh]); }
          } else if (s.kind == K_GLOG) {
#pragma unroll
            for (int i = 0; i < 16; ++i) { const int gg = 32 * mi + crow(i, h); if (hd == 0 && (mi == 0 || i < 8)) p.gates[(size_t)t * 48 + gg] = sigmoid_f(v[i]); }
          }
        }
      }
    }
    __syncthreads();
#pragma unroll 1
    for (int hb = 0; hb < 2; ++hb) {
      const int cb2 = n0 + 64 * hb; int si = 0;
      for (int q = 1; q < nsg; ++q) if (cb2 >= sg[q].nb) si = q;
      const Seg s = sg[si]; const int hd = (cb2 - s.nb) >> 6;
      const bf16_t* Ch = (const bf16_t*)smem + hb * (256 * LSTR);
      const int dil = 1 << s.dlog, L = SEQ >> s.dlog;
      if (s.kind == K_PLAIN || s.kind == K_ROPE) {
#pragma unroll
        for (int q = 0; q < 8; ++q) {
          const int idx = tid + 256 * q, row = idx >> 3, c = idx & 7, t = t0 + row;
          const int b = t >> 12, sq = t & 4095; const size_t rowp = (size_t)(b * dil + (sq & (dil - 1))) * L + (sq >> s.dlog);
          *(u32x4*)((bf16_t*)s.dst + rowp * s.ld + hd * 64 + 8 * c) = *(const u32x4*)(Ch + row * LSTR + 8 * c);
        }
      } else if (s.kind == K_PLAINB) {
#pragma unroll
        for (int q = 0; q < 8; ++q) {
          const int idx = tid + 256 * q, row = idx >> 3, c = idx & 7;
          *(u32x4*)((bf16_t*)s.dst + blk(t0 + row, hd * 64 + 8 * c, NTOK)) = *(const u32x4*)(Ch + row * LSTR + 8 * c);
        }
      } else if (s.kind == K_VT) {
#pragma unroll
        for (int q = 0; q < 8; ++q) {
          const int idx = tid + 256 * q, d = idx >> 5, tc = idx & 31, t = t0 + 8 * tc;
          const u32x4 val = *(const u32x4*)(Ch + d * 264 + 8 * tc);
          const int b = t >> 12, sq = t & 4095;
          if (s.dlog == 0) {
            *(u32x4*)((bf16_t*)s.dst + ((size_t)(b * s.nkv + hd) * 64 + d) * SEQ + sq) = val;
          } else {
            const int rem = idx & 31, rho = rem >> (5 - s.dlog), ck = rem & ((32 >> s.dlog) - 1);
            unsigned wv[4];
#pragma unroll
            for (int e = 0; e < 4; ++e) {
              const unsigned lo = Ch[d * 264 + rho + dil * (8 * ck + 2 * e)], hi = Ch[d * 264 + rho + dil * (8 * ck + 2 * e + 1)];
              wv[e] = lo | (hi << 16);
            }
            const int sq0 = t0 & 4095, b0 = t0 >> 12;
            *(u32x4*)((bf16_t*)s.dst + ((size_t)((b0 * dil + rho) * s.nkv + hd) * 64 + d) * L + (sq0 >> s.dlog) + 8 * ck) = (u32x4){wv[0], wv[1], wv[2], wv[3]};
          }
        }
      }
    }
  } else if (j.epi == E_OUT) {
    bf16_t* Cs = (bf16_t*)smem;
#pragma unroll
    for (int ni = 0; ni < 4; ++ni)
#pragma unroll
      for (int mi = 0; mi < 2; ++mi)
#pragma unroll
        for (int g = 0; g < 4; ++g)
          *(u32x2*)(Cs + (128 * wt + 32 * ni + r) * 136 + 64 * wn + 32 * mi + 8 * g + 4 * h) =
              (u32x2){pack2(acc[mi][ni][4 * g], acc[mi][ni][4 * g + 1]), pack2(acc[mi][ni][4 * g + 2], acc[mi][ni][4 * g + 3])};
    __syncthreads();
#pragma unroll 4
    for (int q = 0; q < 16; ++q) {
      const int idx = tid + 256 * q, row = idx >> 4, col = (idx & 15) * 8;
      const u32x4 av = *(const u32x4*)(Cs + row * 136 + col);
      bf16_t* xq = j.xbp + blk(t0 + row, n0 + col, NTOK);
      float rv[8];
      if (j.res) {
        const f32x4 r0 = *(const f32x4*)(j.res + (size_t)(t0 + row) * 1024 + n0 + col), r1 = *(const f32x4*)(j.res + (size_t)(t0 + row) * 1024 + n0 + col + 4);
        rv[0] = r0[0]; rv[1] = r0[1]; rv[2] = r0[2]; rv[3] = r0[3]; rv[4] = r1[0]; rv[5] = r1[1]; rv[6] = r1[2]; rv[7] = r1[3];
      } else {
        const u32x4 rb = *(const u32x4*)xq;
#pragma unroll
        for (int e = 0; e < 4; ++e) { rv[2 * e] = bflo(rb[e]); rv[2 * e + 1] = bfhi(rb[e]); }
      }
      float o[8]; float ss = 0.f;
#pragma unroll
      for (int e = 0; e < 4; ++e) { o[2 * e] = rv[2 * e] + bflo(av[e]); o[2 * e + 1] = rv[2 * e + 1] + bfhi(av[e]); ss += o[2 * e] * o[2 * e] + o[2 * e + 1] * o[2 * e + 1]; }
      *(u32x4*)xq = (u32x4){pack2(o[0], o[1]), pack2(o[2], o[3]), pack2(o[4], o[5]), pack2(o[6], o[7])};
#pragma unroll
      for (int d = 1; d < 16; d <<= 1) ss += __shfl_xor(ss, d);
      if ((tid & 15) == 0 && j.ssq_out) j.ssq_out[(size_t)(t0 + row) * 8 + nt] = ss;
    }
  } else if (j.epi == E_GELU) {
#pragma unroll
    for (int ni = 0; ni < 4; ++ni) {
      const int t = t0 + 128 * wt + 32 * ni + r;
      if (t < 4080) {
#pragma unroll
        for (int mi = 0; mi < 2; ++mi)
#pragma unroll
          for (int g = 0; g < 4; ++g) {
            const int n = cb + 32 * mi + 8 * g + 4 * h;
            const f32x4 bv = *(const f32x4*)(p.cb + j.kv * 256 + n);
            const float a0 = gelu_tanh(acc[mi][ni][4 * g] + bv[0]), a1 = gelu_tanh(acc[mi][ni][4 * g + 1] + bv[1]);
            const float a2 = gelu_tanh(acc[mi][ni][4 * g + 2] + bv[2]), a3 = gelu_tanh(acc[mi][ni][4 * g + 3] + bv[3]);
            *(u32x2*)(p.hid + ((size_t)j.kv * 4096 + t) * 256 + n) = (u32x2){pack2(a0, a1), pack2(a2, a3)};
          }
      }
    }
  } else {
    if (wn == 0) {
#pragma unroll
      for (int ni = 0; ni < 4; ++ni) {
        const int t = t0 + 128 * wt + 32 * ni + r;
        if (t < 4080) {
          const int g2 = t & 1, bi = t >> 1, b = bi / 255, ci = bi - b * 255;
#pragma unroll
          for (int mi = 0; mi < 2; ++mi) {
            float v[16];
#pragma unroll
            for (int i = 0; i < 16; ++i) v[i] = acc[mi][ni][i];
            if (j.kv == 0) {
              if (mi == 0) {
                const size_t tt = (size_t)b * SEQ + 16 * ci + 31;
#pragma unroll
                for (int i = 0; i < 4; ++i) {
                  const f32x2 cs = p.rope[tt * 8 + 4 * h + i]; const float x1 = v[i], x2 = v[i + 4];
                  v[i] = x1 * cs[0] - x2 * cs[1]; v[i + 4] = x2 * cs[0] + x1 * cs[1];
                }
              }
              bf16_t* dp = p.kcmp + ((size_t)(b * 2 + g2) * 256 + ci) * 64 + 32 * mi + 4 * h;
#pragma unroll
              for (int g = 0; g < 4; ++g) *(u32x2*)(dp + 8 * g) = (u32x2){pack2(v[4 * g], v[4 * g + 1]), pack2(v[4 * g + 2], v[4 * g + 3])};
            } else {
#pragma unroll
              for (int i = 0; i < 16; ++i) p.vtcmp[((size_t)(b * 2 + g2) * 64 + 32 * mi + crow(i, h)) * 256 + ci] = f2bf(v[i]);
            }
          }
        }
      }
    }
  }
}

DI void gemm_phase(const Params& p, const GemmJob& j, int nmt, int ntn, char* smem) {
  const int xcd = blockIdx.x & 7, jl = blockIdx.x >> 3, nloc = (gridDim.x + 7 - xcd) >> 3;
  const int ngroups = nmt >> 2; const int ngx = (ngroups - xcd + 7) >> 3;
  const int per = 4 * ntn, entries = ngx * per;
  for (int e = jl; e < entries; e += nloc) {
    const int gl = e / per, rem = e - gl * per, nt = rem >> 2, m8 = rem & 3;
    const int mt = (gl * 8 + xcd) * 4 + m8;
    gemm_tile(p, j, mt, nt, smem);
  }
}

template <int MODE, bool MASKED, int HM = 3>
DI void attn_tile(const bf16_t* Ks, const bf16_t* Vs, const bf16x8 (&qf)[4], f32x16 (&o)[2], float& m, float& l,
                  int key0, int tq, int maxdist, const float* cn_lds, bool lanesel) {
  constexpr float L2E = 1.4426950408889634f;
  const float NINF = -__builtin_inff();
  const int lane = threadIdx.x & 63, r = lane & 31, h = lane >> 5;
  f32x16 s[2];
#pragma unroll
  for (int k2 = 0; k2 < 2; ++k2) {
    if (!(HM & (1 << k2))) continue;
#pragma unroll
    for (int i = 0; i < 16; ++i) s[k2][i] = 0.f;
#pragma unroll
    for (int ks = 0; ks < 4; ++ks) {
      const bf16x8 a = *(const bf16x8*)(Ks + (32 * k2 + r) * LSTR + 16 * ks + 8 * h);
      s[k2] = mfma32(a, qf[ks], s[k2]);
    }
  }
  if (MODE == 1) {
#pragma unroll
    for (int k2 = 0; k2 < 2; ++k2)
#pragma unroll
      for (int g = 0; g < 4; ++g) {
        if (!(HM & (1 << k2))) continue;
        const f32x4 cv = *(const f32x4*)(cn_lds + key0 + 32 * k2 + 8 * g + 4 * h);
#pragma unroll
        for (int e = 0; e < 4; ++e) s[k2][4 * g + e] = fmaf(s[k2][4 * g + e], L2E, cv[e]);
      }
  }
  float mx = NINF;
#pragma unroll
  for (int k2 = 0; k2 < 2; ++k2)
#pragma unroll
    for (int i = 0; i < 16; ++i) {
      if (!(HM & (1 << k2))) continue;
      float v = s[k2][i];
      if (MASKED) {
        const int tk = key0 + 32 * k2 + crow(i, h);
        const bool valid = (MODE == 0) ? ((tk <= tq) && (tq - tk <= maxdist)) : (tk <= tq);
        v = valid ? v : NINF; s[k2][i] = v;
      }
      mx = fmaxf(mx, v);
    }
  mx = fmaxf(mx, __shfl_xor(mx, 32));
  if (MODE != 1) mx *= L2E;
  if (MODE == 2) mx = lanesel ? mx : NINF;
  const float mn = fmaxf(m, mx); const float alpha = __builtin_amdgcn_exp2f(m - mn);
  const float neg = (MODE == 2 && !lanesel) ? NINF : -mn;
  float ps = 0.f;
#pragma unroll
  for (int k2 = 0; k2 < 2; ++k2)
#pragma unroll
    for (int i = 0; i < 16; ++i) {
      if (!(HM & (1 << k2))) continue;
      const float pv = (MODE == 1) ? __builtin_amdgcn_exp2f(s[k2][i] + neg) : __builtin_amdgcn_exp2f(fmaf(s[k2][i], L2E, neg));
      s[k2][i] = pv; ps += pv;
    }
  l = l * alpha + ps;
  if (__builtin_amdgcn_ballot_w64(mn != m) != 0ull) {
#pragma unroll
    for (int dt = 0; dt < 2; ++dt)
#pragma unroll
      for (int i = 0; i < 16; ++i) o[dt][i] *= alpha;
  }
  m = mn;
#pragma unroll
  for (int st = 0; st < 4; ++st) {
    if (!(HM & (1 << (st >> 1)))) continue;
    const int k2 = st >> 1, b8 = 8 * (st & 1);
    const u32x4 pw = {pack2(s[k2][b8], s[k2][b8 + 1]), pack2(s[k2][b8 + 2], s[k2][b8 + 3]), pack2(s[k2][b8 + 4], s[k2][b8 + 5]), pack2(s[k2][b8 + 6], s[k2][b8 + 7])};
    const bf16x8 pb = __builtin_bit_cast(bf16x8, pw);
#pragma unroll
    for (int dt = 0; dt < 2; ++dt) {
      const s16x4 lo = *(const s16x4*)(Vs + (32 * dt + r) * LSTR + 16 * st + 4 * h);
      const s16x4 hi = *(const s16x4*)(Vs + (32 * dt + r) * LSTR + 16 * st + 8 + 4 * h);
      const bf16x8 a = __builtin_shufflevector(lo, hi, 0, 1, 2, 3, 4, 5, 6, 7);
      o[dt] = mfma32(a, pb, o[dt]);
    }
  }
}

template <int MODE>
DI void flash_loop(char* smem, const bf16_t* Kbase, size_t ldk, const bf16_t* Vtbase, size_t ldv, ull tiles, ull wtiles,
                   const bf16x8 (&qf)[4], f32x16 (&o)[2], float& m, float& l, int tq, int tqmin, int tqmax, int maxdist, const float* cn_lds, ull lmask) {
  const int tid = threadIdx.x; const int c8 = (tid & 7) * 8, lr = tid >> 3;
  if (!tiles) return;
  u32x4 ka[2], va[2], kb[2], vb[2];
  auto issue = [&](int kt, u32x4 (&rk)[2], u32x4 (&rv)[2]) {
#pragma unroll
    for (int q = 0; q < 2; ++q) { rk[q] = *(const u32x4*)(Kbase + (size_t)(64 * kt + lr + 32 * q) * ldk + c8); rv[q] = *(const u32x4*)(Vtbase + (size_t)(lr + 32 * q) * ldv + 64 * kt + c8); }
  };
  auto stash = [&](int stage, const u32x4 (&rk)[2], const u32x4 (&rv)[2]) {
    bf16_t* Ks = (bf16_t*)(smem + stage * (2 * 64 * LSTR * 2)); bf16_t* Vs = Ks + 64 * LSTR;
#pragma unroll
    for (int q = 0; q < 2; ++q) { *(u32x4*)(Ks + (lr + 32 * q) * LSTR + c8) = rk[q]; *(u32x4*)(Vs + (lr + 32 * q) * LSTR + c8) = rv[q]; }
  };
  auto next_tile = [&]() -> int { if (!tiles) return -1; const int t = __builtin_ctzll(tiles); tiles &= tiles - 1; return t; };
  auto compute = [&](int kt, int stage) {
    if (!((wtiles >> kt) & 1ull)) return;
    const bf16_t* Ks = (const bf16_t*)(smem + stage * (2 * 64 * LSTR * 2)); const bf16_t* Vs = Ks + 64 * LSTR;
    const bool sel = ((lmask >> kt) & 1ull) != 0;
    const bool interior = (64 * kt + 63 <= tqmin) && (MODE != 0 || (tqmax - 64 * kt <= maxdist));
    int hm = 3;
    if (MODE == 0) {
      hm = 0;
      if (64 * kt <= tqmax && 64 * kt + 31 >= tqmin - maxdist) hm |= 1;
      if (64 * kt + 32 <= tqmax && 64 * kt + 63 >= tqmin - maxdist) hm |= 2;
    }
    if (MODE == 0 && hm == 1) attn_tile<MODE, true, 1>(Ks, Vs, qf, o, m, l, 64 * kt, tq, maxdist, cn_lds, sel);
    else if (MODE == 0 && hm == 2) attn_tile<MODE, true, 2>(Ks, Vs, qf, o, m, l, 64 * kt, tq, maxdist, cn_lds, sel);
    else if (interior) attn_tile<MODE, false>(Ks, Vs, qf, o, m, l, 64 * kt, tq, maxdist, cn_lds, sel);
    else attn_tile<MODE, true>(Ks, Vs, qf, o, m, l, 64 * kt, tq, maxdist, cn_lds, sel);
  };
  int t0 = next_tile(); issue(t0, ka, va);
  int t1 = next_tile(); if (t1 >= 0) issue(t1, kb, vb);
  while (true) {
    stash(0, ka, va);
    __syncthreads();
    const int t2 = next_tile(); if (t2 >= 0) issue(t2, ka, va);
    compute(t0, 0);
    if (t1 < 0) break;
    stash(1, kb, vb);
    __syncthreads();
    const int t3 = next_tile(); if (t3 >= 0) issue(t3, kb, vb);
    compute(t1, 1);
    if (t2 < 0) break;
    t0 = t2; t1 = t3;
  }
}

DI ull tile_range(int lo, int hi) {
  const ull top = (hi >= 63) ? ~0ull : ((1ull << (hi + 1)) - 1ull);
  return top & ~((1ull << lo) - 1ull);
}

DI void load_q(const bf16_t* qp, bf16x8 (&qf)[4]) {
  const int h = (threadIdx.x & 63) >> 5;
#pragma unroll
  for (int ks = 0; ks < 4; ++ks) qf[ks] = *(const bf16x8*)(qp + 16 * ks + 8 * h);
}

DI void store_gated(const f32x16 (&o)[2], float inv, bf16_t* G, size_t tok, int head) {
  const int h = (otid() & 63) >> 5;
#pragma unroll
  for (int dt = 0; dt < 2; ++dt)
#pragma unroll
    for (int g = 0; g < 4; ++g) {
      bf16_t* q = G + blk(tok, head * 64 + 32 * dt + 8 * g + 4 * h, NTOK);
      const u32x2 gv = *(const u32x2*)q;
      const float a0 = o[dt][4 * g] * inv * silu_f(bflo(gv[0])), a1 = o[dt][4 * g + 1] * inv * silu_f(bfhi(gv[0]));
      const float a2 = o[dt][4 * g + 2] * inv * silu_f(bflo(gv[1])), a3 = o[dt][4 * g + 3] * inv * silu_f(bfhi(gv[1]));
      *(u32x2*)q = (u32x2){pack2(a0, a1), pack2(a2, a3)};
    }
}
DI void store_plain(const f32x16 (&o)[2], float inv, bf16_t* op) {
  const int h = (threadIdx.x & 63) >> 5;
#pragma unroll
  for (int dt = 0; dt < 2; ++dt)
#pragma unroll
    for (int g = 0; g < 4; ++g)
      *(u32x2*)(op + 32 * dt + 8 * g + 4 * h) = (u32x2){pack2(o[dt][4 * g] * inv, o[dt][4 * g + 1] * inv), pack2(o[dt][4 * g + 2] * inv, o[dt][4 * g + 3] * inv)};
}
DI void zero_o(f32x16 (&o)[2]) {
#pragma unroll
  for (int dt = 0; dt < 2; ++dt)
#pragma unroll
    for (int i = 0; i < 16; ++i) o[dt][i] = 0.f;
}


DI void naive_core(const bf16_t* qp, const bf16_t* Kbase, size_t ldk, const bf16_t* Vtbase, size_t ldv, int tq, int klo, int mode, const float* logf, size_t lfs,
                   float m0, float l0, float (&o)[64], float& m_out, float& l_out) {
#pragma unroll
  for (int d = 0; d < 64; ++d) o[d] = 0.f;
  float m = m0, l = l0, D = 0.f;
  for (int tk = tq; tk >= klo; --tk) {
    const bf16_t* kp = Kbase + (size_t)tk * ldk;
    float sc = 0.f;
#pragma unroll
    for (int d = 0; d < 64; d += 2) { const unsigned w = *(const unsigned*)(kp + d); const unsigned qw = *(const volatile unsigned*)(qp + d); sc += bflo(qw) * bflo(w) + bfhi(qw) * bfhi(w); }
    if (mode == 1) sc += D;
    const float mn = fmaxf(m, sc), al = __expf(m - mn), pv = __expf(sc - mn);
    l = l * al + pv; m = mn;
#pragma unroll
    for (int d = 0; d < 64; ++d) o[d] = o[d] * al + pv * bflo((unsigned)Vtbase[(size_t)d * ldv + tk]);
    if (mode == 1) D += logf[(size_t)tk * lfs];
  }
  m_out = m; l_out = l;
}
DI void swa_unit(const Params& p, int u, char* smem, bool probe = false) {
  const int tid = otid(), lane = tid & 63, w = __builtin_amdgcn_readfirstlane(tid >> 6), r = lane & 31, h = lane >> 5;
  const int chunk = u & 127, kvh = (u >> 7) & 3, b = u >> 9;
  const int q0 = chunk * 32, head = kvh * 4 + w, tq = q0 + r; const size_t tok = (size_t)b * SEQ + tq;
  __syncthreads();
  bf16x8 qf[4]; load_q(p.Q + tok * 1024 + head * 64, qf);
  f32x16 o[2]; zero_o(o);
  float m = p.sinks[head] * 1.4426950408889634f, l = (h == 0) ? 1.f : 0.f;
  int lo = (q0 - 127) >> 6; lo = lo < 0 ? 0 : lo; const int hi = (q0 + 31) >> 6;
  const ull tiles = tile_range(lo, hi);
  flash_loop<0>(smem, p.Kb + (size_t)b * SEQ * 256 + kvh * 64, 256, p.Vt + (size_t)(b * 4 + kvh) * 64 * SEQ, SEQ, tiles, tiles, qf, o, m, l, tq, q0, q0 + 31, 127, nullptr, 0ull);
  l += __shfl_xor(l, 32);
  store_gated(o, 1.f / l, p.G, tok, head);
}

DI void dil_unit(const Params& p, int gi, int dlog, int u, char* smem, bool probe = false) {
  const int tid = otid(), lane = tid & 63, w = __builtin_amdgcn_readfirstlane(tid >> 6), r = lane & 31, h = lane >> 5;
  const int L = SEQ >> dlog, nch = L >> 5;
  const int chunk = u % nch, kvh = (u / nch) & 3, bq = u / (nch * 4);
  const int q0 = chunk * 32, head = kvh * 4 + w, tq = q0 + r; const size_t row = (size_t)bq * L + tq;
  __syncthreads();
  bf16_t* Qg = p.Q + (size_t)gi * NTOK * 1024;
  bf16x8 qf[4]; load_q(Qg + row * 1024 + head * 64, qf);
  f32x16 o[2]; zero_o(o);
  float m = -1e30f, l = 0.f;
  int lo = (q0 - 128) >> 6; lo = lo < 0 ? 0 : lo; const int hi = (q0 + 31) >> 6;
  const ull tiles = tile_range(lo, hi);
  flash_loop<0>(smem, p.Kb + (size_t)gi * NTOK * 256 + (size_t)bq * L * 256 + kvh * 64, 256, p.Vt + (size_t)gi * NTOK * 256 + (size_t)(bq * 4 + kvh) * 64 * L, L, tiles, tiles, qf, o, m, l, tq, q0, q0 + 31, 128, nullptr, 0ull);
  l += __shfl_xor(l, 32);
  store_plain(o, 1.f / l, probe ? p.xb + (row & (NTOK - 1)) * 1024 + head * 64 : Qg + row * 1024 + head * 64);
  if (h == 0 && !probe) p.lse[((size_t)gi * NTOK + row) * 16 + head] = m * 0.6931471805599453f + __logf(l);
}

DI void dil_merge_phase(const Params& p, bool probe = false) {
  const size_t gsz = (size_t)gridDim.x * 256, gid = (size_t)blockIdx.x * 256 + otid();
  for (size_t i = gid; i < (size_t)NTOK * 128; i += gsz) {
    const int t = (int)(i >> 7), c = (int)(i & 127), head = c >> 3;
    const int b = t >> 12, sq = t & 4095;
    size_t rows[3]; float ls[3];
#pragma unroll
    for (int gi = 0; gi < 3; ++gi) {
      const int dlog = 2 * gi, dil = 1 << dlog, L = SEQ >> dlog;
      rows[gi] = (size_t)b * SEQ + (size_t)(sq & (dil - 1)) * L + (sq >> dlog);
      ls[gi] = p.lse[((size_t)gi * NTOK + rows[gi]) * 16 + head];
    }
    const float mx = fmaxf(ls[0], fmaxf(ls[1], ls[2]));
    float wg[3]; float den = 0.f;
#pragma unroll
    for (int gi = 0; gi < 3; ++gi) { wg[gi] = __expf(ls[gi] - mx); den += wg[gi]; }
    const float inv = 1.f / den;
    float acc[8] = {0.f, 0.f, 0.f, 0.f, 0.f, 0.f, 0.f, 0.f};
#pragma unroll
    for (int gi = 0; gi < 3; ++gi) {
      const u32x4 ov = *(const u32x4*)(p.Q + (size_t)gi * NTOK * 1024 + rows[gi] * 1024 + c * 8);
      const float wq = wg[gi] * inv;
#pragma unroll
      for (int e = 0; e < 4; ++e) { acc[2 * e] += wq * bflo(ov[e]); acc[2 * e + 1] += wq * bfhi(ov[e]); }
    }
    bf16_t* gp = p.G + blk(t, c * 8, NTOK);
    const u32x4 gv = *(const u32x4*)gp;
    u32x4 ov;
#pragma unroll
    for (int e = 0; e < 4; ++e) ov[e] = pack2(acc[2 * e] * silu_f(bflo(gv[e])), acc[2 * e + 1] * silu_f(bfhi(gv[e])));
    *(u32x4*)gp = ov;
  }
}

DI void fox_unit(const Params& p, int u, char* smem, bool probe = false) {
  const int tid = otid(), lane = tid & 63, w = __builtin_amdgcn_readfirstlane(tid >> 6), r = lane & 31;
  const int qb = 31 - (u >> 7), bh = u & 127, b = bh >> 4, hd = bh & 15;
  float* c_lds = (float*)(smem + 36864); float* wtot = (float*)(smem + 36864 + 16384);
  __syncthreads();
  {
    const int n = 128 * (qb + 1), s0 = tid * 16;
    float v[16]; float run = 0.f;
#pragma unroll
    for (int q = 0; q < 16; ++q) { float lf = 0.f; if (s0 + q < n) lf = p.logf[((size_t)b * SEQ + s0 + q) * 16 + hd]; run += lf; v[q] = run; }
    float inc = run;
#pragma unroll
    for (int d = 1; d < 64; d <<= 1) { const float t = __shfl_up(inc, d); if (lane >= d) inc += t; }
    if (lane == 63) wtot[w] = inc;
    __syncthreads();
    float off = inc - run;
    for (int q = 0; q < w; ++q) off += wtot[q];
    if (s0 < n) {
#pragma unroll
      for (int q = 0; q < 16; ++q) c_lds[s0 + q] = -(v[q] + off) * 1.4426950408889634f;
    }
    __syncthreads();
  }
  const int tq = 128 * qb + 32 * w + r; const size_t tok = (size_t)b * SEQ + tq;
  bf16x8 qf[4]; load_q(p.Q + tok * 1024 + hd * 64, qf);
  f32x16 o[2]; zero_o(o);
  float m = -1e30f, l = 0.f;
  const ull tiles = tile_range(0, 2 * qb + 1);
  const ull wtiles = tile_range(0, (128 * qb + 32 * w + 31) >> 6);
  flash_loop<1>(smem, p.Kb + (size_t)b * SEQ * 1024 + hd * 64, 1024, p.Vt + (size_t)(b * 16 + hd) * 64 * SEQ, SEQ, tiles, wtiles, qf, o, m, l, tq, 128 * qb + 32 * w, 128 * qb + 32 * w + 31, 0, c_lds, 0ull);
  l += __shfl_xor(l, 32);
  store_gated(o, 1.f / l, p.G, tok, hd);
}

DI void nsa_win_unit(const Params& p, int u, char* smem) {
  const int tid = otid(), lane = tid & 63, w = __builtin_amdgcn_readfirstlane(tid >> 6), r = lane & 31;
  const int chunk = u & 127, hh = (u >> 7) & 1, g = (u >> 8) & 1, b = u >> 9;
  const int q0 = chunk * 32, head = 8 * g + 4 * hh + w, tq = q0 + r; const size_t tok = (size_t)b * SEQ + tq;
  __syncthreads();
  bf16x8 qf[4]; load_q(p.Q + tok * 1024 + head * 64, qf);
  f32x16 o[2]; zero_o(o);
  float m = -1e30f, l = 0.f;
  int lo = (q0 - 255) >> 6; lo = lo < 0 ? 0 : lo; const int hi = (q0 + 31) >> 6;
  const ull tiles = tile_range(lo, hi);
  flash_loop<0>(smem, p.Kb + (size_t)NTOK * 384 + (size_t)b * SEQ * 128 + g * 64, 128, p.Vt + (size_t)NTOK * 128 + (size_t)(b * 2 + g) * 64 * SEQ, SEQ, tiles, tiles, qf, o, m, l, tq, q0, q0 + 31, 255, nullptr, 0ull);
  l += __shfl_xor(l, 32);
  store_plain(o, 1.f / l, p.Q + (size_t)2 * NTOK * 1024 + tok * 1024 + head * 64);
}

DI void nsa_cmp_unit(const Params& p, int u, char* smem) {
  const int tid = otid(), lane = tid & 63, w = __builtin_amdgcn_readfirstlane(tid >> 6), r = lane & 31, h = lane >> 5;
  const int qb = u & 31, g = (u >> 5) & 1, b = u >> 6;
  constexpr int VSTR = 264;
  bf16_t* Kc = (bf16_t*)smem; bf16_t* Vc = (bf16_t*)(smem + 36864);
  __syncthreads();
  {
    const bf16_t* ksrc = p.kcmp + (size_t)(b * 2 + g) * 256 * 64; const bf16_t* vsrc = p.vtcmp + (size_t)(b * 2 + g) * 64 * 256;
#pragma unroll
    for (int q = 0; q < 8; ++q) {
      const int idx = tid + 256 * q;
      *(u32x4*)(Kc + (idx >> 3) * LSTR + (idx & 7) * 8) = *(const u32x4*)(ksrc + (size_t)idx * 8);
      *(u32x4*)(Vc + (idx >> 5) * VSTR + (idx & 31) * 8) = *(const u32x4*)(vsrc + (size_t)idx * 8);
    }
  }
  __syncthreads();
  const int q0 = 128 * qb + 32 * w, tq = q0 + r; const size_t tok = (size_t)b * SEQ + tq;
  const int nc = tq >= 31 ? ((tq - 31) >> 4) + 1 : 0;
  const int ncw = (q0 >> 4) + 1; int ntile = (ncw + 31) >> 5; ntile = ntile > 8 ? 8 : ntile;
  f32x16 imp[2];
#pragma unroll
  for (int jt = 0; jt < 2; ++jt)
#pragma unroll
    for (int i = 0; i < 16; ++i) imp[jt][i] = 0.f;
#pragma unroll 1
  for (int hd = 0; hd < 8; ++hd) {
    const int head = 8 * g + hd;
    bf16x8 qf[4]; load_q(p.Q + tok * 1024 + head * 64, qf);
    float m = -1e30f, l = 0.f;
#pragma unroll 1
    for (int T = 0; T < ntile; ++T) {
      f32x16 s;
#pragma unroll
      for (int i = 0; i < 16; ++i) s[i] = 0.f;
#pragma unroll
      for (int ks = 0; ks < 4; ++ks) s = mfma32(*(const bf16x8*)(Kc + (32 * T + r) * LSTR + 16 * ks + 8 * h), qf[ks], s);
      float mx = -1e30f;
#pragma unroll
      for (int i = 0; i < 16; ++i) { const bool valid = (32 * T + crow(i, h)) < nc; const float v = valid ? s[i] : -1e30f; s[i] = v; mx = fmaxf(mx, v); }
      mx = fmaxf(mx, __shfl_xor(mx, 32));
      const float mn = fmaxf(m, mx); float ps = 0.f;
#pragma unroll
      for (int i = 0; i < 16; ++i) ps += s[i] > -5e29f ? __expf(s[i] - mn) : 0.f;
      l = l * __expf(m - mn) + ps; m = mn;
    }
    l += __shfl_xor(l, 32);
    const float inv = l > 0.f ? 1.f / l : 0.f;
    f32x16 o[2]; zero_o(o);
#pragma unroll 1
    for (int T = 0; T < ntile; ++T) {
      f32x16 s;
#pragma unroll
      for (int i = 0; i < 16; ++i) s[i] = 0.f;
#pragma unroll
      for (int ks = 0; ks < 4; ++ks) s = mfma32(*(const bf16x8*)(Kc + (32 * T + r) * LSTR + 16 * ks + 8 * h), qf[ks], s);
#pragma unroll
      for (int i = 0; i < 16; ++i) { const bool valid = (32 * T + crow(i, h)) < nc; s[i] = valid ? __expf(s[i] - m) * inv : 0.f; }
#pragma unroll
      for (int st = 0; st < 2; ++st) {
        u32x4 ph, pl;
#pragma unroll
        for (int e = 0; e < 4; ++e) {
          const float a0 = s[8 * st + 2 * e], a1 = s[8 * st + 2 * e + 1];
          const unsigned hw = pack2(a0, a1); ph[e] = hw; pl[e] = pack2(a0 - bflo(hw), a1 - bfhi(hw));
        }
        const bf16x8 pbh = __builtin_bit_cast(bf16x8, ph), pbl = __builtin_bit_cast(bf16x8, pl);
#pragma unroll
        for (int dt = 0; dt < 2; ++dt) {
          const s16x4 lo = *(const s16x4*)(Vc + (32 * dt + r) * VSTR + 32 * T + 16 * st + 4 * h);
          const s16x4 hi = *(const s16x4*)(Vc + (32 * dt + r) * VSTR + 32 * T + 16 * st + 8 + 4 * h);
          o[dt] = mfma32(__builtin_shufflevector(lo, hi, 0, 1, 2, 3, 4, 5, 6, 7), pbh, o[dt]);
        }
#pragma unroll
        for (int jt = 0; jt < 2; ++jt) {
          if ((jt == 0 && T <= 3) || (jt == 1 && T >= 3)) {
            const int base = 32 * T + 16 * st + 4 * h - 128 * jt - 4 * r;
            bf16x8 ov;
#pragma unroll
            for (int jj = 0; jj < 8; ++jj) {
              const int d = base + 8 * (jj >> 2) + (jj & 3);
              ov[jj] = (short)((d == -1 || d == 3) ? 0x3F00 : ((d >= 0 && d <= 2) ? 0x3F80 : 0));
            }
            imp[jt] = mfma32(ov, pbh, imp[jt]);
            imp[jt] = mfma32(ov, pbl, imp[jt]);
          }
        }
      }
    }
    store_plain(o, 1.f, p.Q + (size_t)NTOK * 1024 + tok * 1024 + head * 64);
  }
  __syncthreads();
  float* imp_s = (float*)smem;
#pragma unroll
  for (int jt = 0; jt < 2; ++jt)
#pragma unroll
    for (int i = 0; i < 16; ++i) imp_s[(32 * w + r) * 65 + 32 * jt + crow(i, h)] = imp[jt][i];
  __syncthreads();
  if (tid < 128) {
    const int t = 128 * qb + tid, cur = t >> 6;
    ull mask = 1ull | (1ull << cur);
    if (cur >= 2) {
      const int need = (cur - 1) < 6 ? (cur - 1) : 6;
      for (int k = 0; k < need; ++k) {
        int best = 1; float bv = -1.f;
        for (int jj = 1; jj < cur; ++jj) {
          const float v = imp_s[tid * 65 + jj];
          if (!((mask >> jj) & 1ull) && v > bv) { bv = v; best = jj; }
        }
        mask |= 1ull << best;
      }
    }
    p.selmask[(size_t)(b * 2 + g) * SEQ + t] = mask;
  }
}

DI void nsa_slc_unit(const Params& p, int u, char* smem, bool probe = false) {
  const int tid = otid(), lane = tid & 63, w = __builtin_amdgcn_readfirstlane(tid >> 6), r = lane & 31, h = lane >> 5;
  const int chunk = u & 255, g = (u >> 8) & 1, b = u >> 9;
  const int q0 = 16 * chunk, qi = r >> 3, hd = r & 7, tq = q0 + 4 * w + qi, head = 8 * g + hd; const size_t tok = (size_t)b * SEQ + tq;
  __syncthreads();
  const ull* sm = p.selmask + (size_t)(b * 2 + g) * SEQ + q0;
  ull U = 0ull, Wm = 0ull;
#pragma unroll
  for (int i = 0; i < 16; ++i) U |= sm[i];
#pragma unroll
  for (int i = 0; i < 4; ++i) Wm |= sm[4 * w + i];
  const ull lm = sm[4 * w + qi];
  bf16x8 qf[4]; load_q(p.Q + tok * 1024 + head * 64, qf);
  f32x16 o[2]; zero_o(o);
  float m = -1e30f, l = 0.f;
  flash_loop<2>(smem, p.Kb + (size_t)NTOK * 256 + (size_t)b * SEQ * 128 + g * 64, 128, p.Vt + (size_t)(b * 2 + g) * 64 * SEQ, SEQ, U, Wm, qf, o, m, l, tq, q0 + 4 * w, q0 + 4 * w + 3, 0, nullptr, lm);
  l += __shfl_xor(l, 32);
  const float inv = 1.f / l;
  const float g0 = p.gates[tok * 48 + head * 3], g1 = p.gates[tok * 48 + head * 3 + 1] * inv, g2 = p.gates[tok * 48 + head * 3 + 2];
  const bf16_t* oc = p.Q + (size_t)NTOK * 1024 + tok * 1024 + head * 64; const bf16_t* ow = p.Q + (size_t)2 * NTOK * 1024 + tok * 1024 + head * 64;
#pragma unroll
  for (int dt = 0; dt < 2; ++dt)
#pragma unroll
    for (int g4 = 0; g4 < 4; ++g4) {
      const int d = 32 * dt + 8 * g4 + 4 * h;
      bf16_t* gp = p.G + blk(tok, head * 64 + d, NTOK);
      const u32x2 cv = *(const u32x2*)(oc + d), wv = *(const u32x2*)(ow + d), gv = *(const u32x2*)gp;
      const float a0 = (g0 * bflo(cv[0]) + g1 * o[dt][4 * g4] + g2 * bflo(wv[0])) * silu_f(bflo(gv[0]));
      const float a1 = (g0 * bfhi(cv[0]) + g1 * o[dt][4 * g4 + 1] + g2 * bfhi(wv[0])) * silu_f(bfhi(gv[0]));
      const float a2 = (g0 * bflo(cv[1]) + g1 * o[dt][4 * g4 + 2] + g2 * bflo(wv[1])) * silu_f(bflo(gv[1]));
      const float a3 = (g0 * bfhi(cv[1]) + g1 * o[dt][4 * g4 + 3] + g2 * bfhi(wv[1])) * silu_f(bfhi(gv[1]));
      *(u32x2*)gp = (u32x2){pack2(a0, a1), pack2(a2, a3)};
    }
}


DI void naive_swa_phase(const Params& p) {
  const size_t gsz = (size_t)gridDim.x * 256, gid = (size_t)blockIdx.x * 256 + otid();
  for (size_t idx = gid; idx < (size_t)NTOK * 16; idx += gsz) {
    const int head = (int)(idx & 15), kvh = head >> 2; const size_t tok = idx >> 4; const int b = (int)(tok >> 12), tq = (int)(tok & 4095);
    float o[64], m, l;
    naive_core(p.Q + tok * 1024 + head * 64, p.Kb + (size_t)b * SEQ * 256 + kvh * 64, 256, p.Vt + (size_t)(b * 4 + kvh) * 64 * SEQ, SEQ, tq, tq - 127 < 0 ? 0 : tq - 127, 0, nullptr, 0,
               p.sinks[head], 1.f, o, m, l);
    bf16_t* gp = p.G + tok * 1024 + head * 64; const float inv = 1.f / l;
#pragma unroll
    for (int d = 0; d < 64; d += 2) { const unsigned gv = *(const unsigned*)(gp + d); *(unsigned*)(gp + d) = pack2(o[d] * inv * silu_f(bflo(gv)), o[d + 1] * inv * silu_f(bfhi(gv))); }
  }
}
DI void naive_dil_phase(const Params& p) {
  const size_t gsz = (size_t)gridDim.x * 256, gid = (size_t)blockIdx.x * 256 + otid();
  for (size_t idx = gid; idx < (size_t)3 * NTOK * 16; idx += gsz) {
    const int gi = (int)(idx / ((size_t)NTOK * 16)); const size_t rem = idx - (size_t)gi * NTOK * 16;
    const int dlog = 2 * gi, L = SEQ >> dlog;
    const int head = (int)(rem & 15), kvh = head >> 2; const size_t row = rem >> 4; const int bq = (int)(row / L), tq = (int)(row - (size_t)bq * L);
    float o[64], m, l;
    bf16_t* Qg = p.Q + (size_t)gi * NTOK * 1024;
    naive_core(Qg + row * 1024 + head * 64, p.Kb + (size_t)gi * NTOK * 256 + (size_t)bq * L * 256 + kvh * 64, 256, p.Vt + (size_t)gi * NTOK * 256 + (size_t)(bq * 4 + kvh) * 64 * L, L,
               tq, tq - 128 < 0 ? 0 : tq - 128, 0, nullptr, 0, -1e30f, 0.f, o, m, l);
    bf16_t* op = Qg + row * 1024 + head * 64; const float inv = 1.f / l;
#pragma unroll
    for (int d = 0; d < 64; d += 2) *(unsigned*)(op + d) = pack2(o[d] * inv, o[d + 1] * inv);
    p.lse[((size_t)gi * NTOK + row) * 16 + head] = m + __logf(l);
  }
}
DI void naive_win_phase(const Params& p) {
  const size_t gsz = (size_t)gridDim.x * 256, gid = (size_t)blockIdx.x * 256 + otid();
  for (size_t idx = gid; idx < (size_t)NTOK * 16; idx += gsz) {
    const int head = (int)(idx & 15), g = head >> 3; const size_t tok = idx >> 4; const int b = (int)(tok >> 12), tq = (int)(tok & 4095);
    float o[64], m, l;
    naive_core(p.Q + tok * 1024 + head * 64, p.Kb + (size_t)NTOK * 384 + (size_t)b * SEQ * 128 + g * 64, 128, p.Vt + (size_t)NTOK * 128 + (size_t)(b * 2 + g) * 64 * SEQ, SEQ,
               tq, tq - 255 < 0 ? 0 : tq - 255, 0, nullptr, 0, -1e30f, 0.f, o, m, l);
    bf16_t* op = p.Q + (size_t)2 * NTOK * 1024 + tok * 1024 + head * 64; const float inv = 1.f / l;
#pragma unroll
    for (int d = 0; d < 64; d += 2) *(unsigned*)(op + d) = pack2(o[d] * inv, o[d + 1] * inv);
  }
}
DI void naive_fox_phase(const Params& p) {
  const size_t gsz = (size_t)gridDim.x * 256, gid = (size_t)blockIdx.x * 256 + otid();
  for (size_t idx = gid; idx < (size_t)NTOK * 16; idx += gsz) {
    const int head = (int)(idx / NTOK); const size_t tok = idx - (size_t)head * NTOK; const int b = (int)(tok >> 12), tq = (int)(tok & 4095);
    float o[64], m, l;
    naive_core(p.Q + tok * 1024 + head * 64, p.Kb + (size_t)b * SEQ * 1024 + head * 64, 1024, p.Vt + (size_t)(b * 16 + head) * 64 * SEQ, SEQ,
               tq, 0, 1, p.logf + (size_t)b * SEQ * 16 + head, 16, -1e30f, 0.f, o, m, l);
    bf16_t* gp = p.G + tok * 1024 + head * 64; const float inv = 1.f / l;
#pragma unroll
    for (int d = 0; d < 64; d += 2) { const unsigned gv = *(const unsigned*)(gp + d); *(unsigned*)(gp + d) = pack2(o[d] * inv * silu_f(bflo(gv)), o[d + 1] * inv * silu_f(bfhi(gv))); }
  }
}

DI void final_norm_phase(const Params& p) {
  const int tid = otid(), lane = tid & 63; const int wv = blockIdx.x * 4 + (tid >> 6), nw = gridDim.x * 4;
  for (int t = wv; t < NTOK; t += nw) {
    const bf16_t* src = p.xb + blk(t, lane * 16, NTOK);
    const u32x4 a = *(const u32x4*)src, b = *(const u32x4*)(src + 8);
    float v[16]; float ss = 0.f;
#pragma unroll
    for (int e = 0; e < 4; ++e) { v[2 * e] = bflo(a[e]); v[2 * e + 1] = bfhi(a[e]); v[8 + 2 * e] = bflo(b[e]); v[8 + 2 * e + 1] = bfhi(b[e]); }
#pragma unroll
    for (int i = 0; i < 16; ++i) ss += v[i] * v[i];
#pragma unroll
    for (int d = 1; d < 64; d <<= 1) ss += __shfl_xor(ss, d);
    const float rs = rsqrtf(ss * (1.f / 1024.f) + 1e-6f);
    float* row = p.out + (size_t)t * 1024 + lane * 16;
#pragma unroll
    for (int i = 0; i < 4; ++i) {
      const f32x4 gn = *(const f32x4*)(p.final_norm + lane * 16 + 4 * i);
      f32x4 o; o[0] = v[4 * i] * rs * gn[0]; o[1] = v[4 * i + 1] * rs * gn[1]; o[2] = v[4 * i + 2] * rs * gn[2]; o[3] = v[4 * i + 3] * rs * gn[3];
      *(f32x4*)(row + 4 * i) = o;
    }
  }
}


DI void gbar(unsigned* bar, unsigned k) {
  asm volatile("s_waitcnt vmcnt(0)" ::: "memory");
  __syncthreads();
  if (threadIdx.x == 0) {
    const unsigned G = gridDim.x, grp = blockIdx.x & 7u, ng = (G + 7u - grp) >> 3, ngroups = G < 8u ? G : 8u;
    __builtin_amdgcn_fence(__ATOMIC_RELEASE, "agent");
    asm volatile("s_waitcnt vmcnt(0)" ::: "memory");
    const unsigned old = __hip_atomic_fetch_add(bar + 64 * grp, 1u, __ATOMIC_RELAXED, __HIP_MEMORY_SCOPE_AGENT);
    if (old + 1u == ng * k) {
      const unsigned o2 = __hip_atomic_fetch_add(bar + 64 * 8, 1u, __ATOMIC_RELAXED, __HIP_MEMORY_SCOPE_AGENT);
      if (o2 + 1u == ngroups * k) {
        for (unsigned g = 0; g < 8u; ++g) __hip_atomic_store(bar + 64 * (9 + g), k, __ATOMIC_RELAXED, __HIP_MEMORY_SCOPE_AGENT);
      }
    }
    while (__hip_atomic_load(bar + 64 * (9 + grp), __ATOMIC_RELAXED, __HIP_MEMORY_SCOPE_AGENT) < k) __builtin_amdgcn_s_sleep(1);
    __builtin_amdgcn_fence(__ATOMIC_ACQUIRE, "agent");
    asm volatile("s_waitcnt vmcnt(0)" ::: "memory");
  }
  __syncthreads();
}

DI int balance_unit(int u, int G) {
  const int k = u / G, i = u - k * G;
  return (k & 1) ? (k * G + (G - 1 - i)) : u;
}


__global__ void __launch_bounds__(256, 2) mega_kernel(Params p) {
  extern __shared__ __attribute__((aligned(16))) char smem[];
  cg::grid_group grid = cg::this_grid();
  const int G = gridDim.x;
  unsigned bk = 0;
  if (blockIdx.x == 0 && threadIdx.x < 17) __hip_atomic_store(p.bar + 64 * threadIdx.x, 0u, __ATOMIC_RELAXED, __HIP_MEMORY_SCOPE_AGENT);
#if PROBE_PREP
  prep_phase(p, smem);
#endif
  prep_phase(p, smem);
  grid.sync();
#pragma unroll 1
  for (int layer = 0; layer < 4; ++layer) {
    if (layer == 0 && blockIdx.x == G - 1) {
      for (int n = otid(); n < 512; n += 256) {
        float a = 0.f; const int kv = n >> 8, c = n & 255;
        for (int ch = 0; ch < 32; ++ch) a += p.cbp[(kv * 32 + ch) * 256 + c];
        p.cb[n] = a;
      }
    }
    {
      GemmJob j; j.ablk = 0; j.bblk = 0; j.A = p.xb; j.Bt = p.wt_in[layer]; j.lda = 1024; j.K = 1024; j.amode = 0; j.epi = E_SEG; j.layer = layer; j.kv = 0; j.res = nullptr; j.ablk = NTOK; j.bblk = p.npad[layer];
      gemm_phase(p, j, 128, p.npad[layer] >> 7, smem);
    }
    gbar(p.bar, ++bk);
    if (layer == 0) {
#if DBG_SWA
      naive_swa_phase(p);
#else
#if PROBE_SWA
      for (int u = blockIdx.x; u < 4096; u += G) swa_unit(p, u, smem, true);
#endif
      for (int u = blockIdx.x; u < 4096; u += G) swa_unit(p, u, smem);
#endif
    } else if (layer == 1) {
#if DBG_DIL
      naive_dil_phase(p);
#else
#if PROBE_DIL
      for (int u = blockIdx.x; u < 3 * 4096; u += G) { const int gi = u >> 12; dil_unit(p, gi, 2 * gi, u & 4095, smem, true); }
#endif
      for (int u = blockIdx.x; u < 3 * 4096; u += G) { const int gi = u >> 12; dil_unit(p, gi, 2 * gi, u & 4095, smem); }
#endif
      gbar(p.bar, ++bk);
#if PROBE_MERGE
      dil_merge_phase(p, true);
#endif
      dil_merge_phase(p);
    } else if (layer == 2) {
#if DBG_FOX
      naive_fox_phase(p);
#else
#if PROBE_FOX
      for (int u = blockIdx.x; u < 4096; u += G) fox_unit(p, balance_unit(u, G), smem, true);
#endif
      for (int u = blockIdx.x; u < 4096; u += G) fox_unit(p, balance_unit(u, G), smem);
#endif
    } else {
      for (int e = blockIdx.x; e < 64; e += G) {
        const int kv = e >> 5;
        GemmJob j; j.ablk = 0; j.bblk = 0; j.A = p.Kb + kv * 128; j.Bt = p.wt_c1[kv]; j.lda = 256; j.K = 2048; j.amode = 1; j.epi = E_GELU; j.layer = 3; j.kv = kv; j.res = nullptr;
        gemm_tile(p, j, (e >> 1) & 15, e & 1, smem);
      }
#if DBG_WIN
      naive_win_phase(p);
#else
#if PROBE_WIN
      for (int u = blockIdx.x; u < 2048; u += G) nsa_win_unit(p, u, smem);
      if (G == 512) { if (blockIdx.x >= 64) for (int u = blockIdx.x - 64; u < 2048; u += 448) nsa_win_unit(p, u, smem); }
      else for (int u = blockIdx.x; u < 2048; u += G) nsa_win_unit(p, u, smem);
#endif
      if (G == 512) { if (blockIdx.x >= 64) for (int u = blockIdx.x - 64; u < 2048; u += 448) nsa_win_unit(p, u, smem); }
      else for (int u = blockIdx.x; u < 2048; u += G) nsa_win_unit(p, u, smem);
#endif
      gbar(p.bar, ++bk);
      for (int e = blockIdx.x; e < 32; e += G) {
        const int kv = e >> 4;
        GemmJob j; j.ablk = 0; j.bblk = 0; j.A = p.hid + (size_t)kv * 4096 * 256; j.Bt = p.wt_c2[kv]; j.lda = 256; j.K = 256; j.amode = 0; j.epi = E_CMP2; j.layer = 3; j.kv = kv; j.res = nullptr;
        gemm_tile(p, j, e & 15, 0, smem);
      }
#if !DBG_WIN
      if (G != 512) for (int u = 2048 + blockIdx.x; u < 4096; u += G) nsa_win_unit(p, u, smem);
#endif
      gbar(p.bar, ++bk);
#if PROBE_CMP
      for (int u = blockIdx.x; u < 512; u += G) nsa_cmp_unit(p, u, smem);
#endif
      for (int u = blockIdx.x; u < 512; u += G) nsa_cmp_unit(p, u, smem);
      if (G == 512) {
        const int qb = blockIdx.x & 31, grp = blockIdx.x >> 5;
        int c0 = 0;
        for (int q = 0; q < qb; ++q) c0 += ((31 - q) * 8 + 15) / 31;
        const int n = ((31 - qb) * 8 + 15) / 31;
        for (int k = 0; k < n; ++k) nsa_win_unit(p, 2048 + grp * 128 + c0 + k, smem);
      }
      gbar(p.bar, ++bk);
#if PROBE_SLC
      for (int u = blockIdx.x; u < 4096; u += G) nsa_slc_unit(p, u, smem, true);
#endif
      for (int u = blockIdx.x; u < 4096; u += G) {
        const int v = balance_unit(u, G), ch = 255 - (v >> 4), gb = v & 15;
        nsa_slc_unit(p, ((gb >> 1) << 9) | ((gb & 1) << 8) | ch, smem);
      }
    }
    gbar(p.bar, ++bk);
    {
      GemmJob j; j.ablk = 0; j.bblk = 0; j.A = p.G; j.Bt = p.wt_out[layer]; j.lda = 1024; j.K = 1024; j.amode = 0; j.epi = E_OUT; j.layer = layer; j.kv = 0; j.res = (layer == 0) ? p.x : (const float*)nullptr; j.outp = p.out; j.xbp = p.xb; j.ssq_out = p.ssqp; j.ablk = NTOK; j.bblk = 1024;
#if PROBE_GOUT
      { GemmJob j2 = j; j2.outp = (float*)p.Q; j2.xbp = p.Kb; j2.ssq_out = nullptr; gemm_phase(p, j2, 128, 8, smem); }
#endif
      gemm_phase(p, j, 128, 8, smem);
    }
    gbar(p.bar, ++bk);
  }
  final_norm_phase(p);
}

static void add_seg(Params& p, int layer, int nb, int kind, void* dst, int ld, int dlog, int nkv, float scale) {
  Seg& s = p.segs[layer][p.nseg[layer]++];
  s.dst = dst; s.nb = nb; s.kind = kind; s.dlog = dlog; s.ld = ld; s.nkv = nkv; s.scale = scale;
}

extern "C" void kernel_launch(void* const* d_in, const int* in_sizes, int n_in, void* d_out, int out_size, void* d_ws, size_t ws_size, hipStream_t stream) {
  constexpr size_t MiB = 1u << 20;
  constexpr size_t OFF_WIN = 0, OFF_WOUT = 31457280, OFF_WC1 = 39845888, OFF_WC2 = 41943040, OFF_CBP = 42074112, OFF_CB = 42139648;
  constexpr size_t OFF_ROPE = 42 * MiB, OFF_XB = 44 * MiB, OFF_Q = 108 * MiB, OFF_K = 300 * MiB, OFF_VT = 364 * MiB, OFF_G = 428 * MiB, OFF_SM = 492 * MiB, WS_END = 504 * MiB;
  static int grid_blocks = 0;
  if (grid_blocks == 0) {
    if (n_in != 23 || ws_size < WS_END) { fprintf(stderr, "kernel_launch: unexpected n_in %d or ws_size %zu (need %zu)\n", n_in, ws_size, (size_t)WS_END); grid_blocks = -1; return; }
    int dev = 0, cus = 0, per_cu = 0;
    hipGetDevice(&dev);
    hipDeviceGetAttribute(&cus, hipDeviceAttributeMultiprocessorCount, dev);
    if (hipFuncSetAttribute((const void*)mega_kernel, hipFuncAttributeMaxDynamicSharedMemorySize, LDS_BYTES) != hipSuccess) { fprintf(stderr, "hipFuncSetAttribute failed\n"); grid_blocks = -1; return; }
    if (hipOccupancyMaxActiveBlocksPerMultiprocessor(&per_cu, (const void*)mega_kernel, 256, LDS_BYTES) != hipSuccess || per_cu < 1) { fprintf(stderr, "occupancy query failed (%d)\n", per_cu); (void)hipGetLastError(); grid_blocks = -1; return; }
    if (per_cu > 2) per_cu = 2;
    grid_blocks = cus * per_cu;
    fprintf(stderr, "kernel_launch: cus %d per_cu %d grid %d\n", cus, per_cu, grid_blocks);
  }
  if (grid_blocks < 0) return;
  char* ws = (char*)d_ws;
  Params p;
  memset(&p, 0, sizeof(p));
  const float* const* in = (const float* const*)d_in;
  p.x = in[0]; p.pos = (const int*)d_in[1];
  const float* norm[4] = {in[2], in[6], in[9], in[13]};
  const float* w_in[4] = {in[3], in[7], in[10], in[14]};
  p.sinks = in[4]; p.b_f = in[11];
  p.w_out[0] = in[5]; p.w_out[1] = in[8]; p.w_out[2] = in[12]; p.w_out[3] = in[21];
  p.pe[0] = in[15]; p.w1[0] = in[16]; const float* w2k = in[17];
  p.pe[1] = in[18]; p.w1[1] = in[19]; const float* w2v = in[20];
  p.final_norm = in[22];
  p.out = (float*)d_out;
  const int nsrc[4] = {2560, 5632, 4112, 2864}; const int npad[4] = {2560, 5632, 4224, 2944}; const int maps[4] = {0, 0, 2, 3};
  size_t wo = 0;
  for (int l = 0; l < 4; ++l) { p.wt_in[l] = (bf16_t*)(ws + OFF_WIN) + wo; wo += (size_t)npad[l] * 1024; p.wt_out[l] = (bf16_t*)(ws + OFF_WOUT) + (size_t)l * 1024 * 1024; p.npad[l] = npad[l]; }
  for (int kv = 0; kv < 2; ++kv) { p.wt_c1[kv] = (bf16_t*)(ws + OFF_WC1) + (size_t)kv * 256 * 2048; p.wt_c2[kv] = (bf16_t*)(ws + OFF_WC2) + (size_t)kv * 128 * 256; }
  p.cbp = (float*)(ws + OFF_CBP); p.cb = (float*)(ws + OFF_CB); p.bar = (unsigned*)(ws + 41 * MiB + 768 * 1024); p.ssqp = (float*)(ws + 40 * MiB + 512 * 1024);
  p.rope = (f32x2*)(ws + OFF_ROPE); p.xb = (bf16_t*)(ws + OFF_XB); p.Q = (bf16_t*)(ws + OFF_Q); p.Kb = (bf16_t*)(ws + OFF_K); p.Vt = (bf16_t*)(ws + OFF_VT); p.G = (bf16_t*)(ws + OFF_G);
  p.lse = (float*)(ws + OFF_SM); p.logf = (float*)(ws + OFF_SM); p.gates = (float*)(ws + OFF_SM);
  p.selmask = (ull*)(ws + OFF_SM + 6 * MiB); p.hid = (bf16_t*)(ws + OFF_SM + 7 * MiB); p.kcmp = (bf16_t*)(ws + OFF_SM + 11 * MiB); p.vtcmp = (bf16_t*)(ws + OFF_SM + 11 * MiB + 512 * 1024);
  int nt = 0, tiles = 0;
  auto add_tj = [&](const float* src, bf16_t* dst, const float* gain, int ksrc, int ns, int nd, int map) {
    TJob& t = p.tj[nt++]; t.src = src; t.dst = dst; t.gain = gain; t.ksrc = ksrc; t.nsrc = ns; t.ndst = nd; t.map = map; t.tile0 = tiles; t.blk = (ksrc == 1024) ? 1 : 0;
    tiles += (nd / 64) * (ksrc / 64);
  };
  for (int l = 0; l < 4; ++l) add_tj(w_in[l], p.wt_in[l], norm[l], 1024, nsrc[l], npad[l], maps[l]);
  for (int l = 0; l < 4; ++l) add_tj(p.w_out[l], p.wt_out[l], nullptr, 1024, 1024, 1024, 0);
  add_tj(p.w1[0], p.wt_c1[0], nullptr, 2048, 256, 256, 0);
  add_tj(p.w1[1], p.wt_c1[1], nullptr, 2048, 256, 256, 0);
  add_tj(w2k, p.wt_c2[0], nullptr, 256, 64, 128, 0);
  add_tj(w2v, p.wt_c2[1], nullptr, 256, 64, 128, 0);
  p.ntj = nt; p.ttiles = tiles;
  for (int i = 0; i < 8; ++i) p.inv_freq[i] = (float)pow(500000.0, -(double)i / 8.0);
  const size_t NT = (size_t)NTOK;
  add_seg(p, 0, 0, K_ROPE, p.Q, 1024, 0, 0, 0.125f);
  add_seg(p, 0, 1024, K_ROPE, p.Kb, 256, 0, 0, 1.f);
  add_seg(p, 0, 1280, K_VT, p.Vt, 0, 0, 4, 1.f);
  add_seg(p, 0, 1536, K_PLAINB, p.G, 1024, 0, 0, 1.f);
  for (int gi = 0; gi < 3; ++gi) {
    add_seg(p, 1, 1536 * gi, K_ROPE, p.Q + gi * NT * 1024, 1024, 2 * gi, 0, 0.125f);
    add_seg(p, 1, 1536 * gi + 1024, K_ROPE, p.Kb + gi * NT * 256, 256, 2 * gi, 0, 1.f);
    add_seg(p, 1, 1536 * gi + 1280, K_VT, p.Vt + gi * NT * 256, 0, 2 * gi, 4, 1.f);
  }
  add_seg(p, 1, 4608, K_PLAINB, p.G, 1024, 0, 0, 1.f);
  add_seg(p, 2, 0, K_PLAIN, p.Q, 1024, 0, 0, 0.125f);
  add_seg(p, 2, 1024, K_PLAIN, p.Kb, 1024, 0, 0, 1.f);
  add_seg(p, 2, 2048, K_VT, p.Vt, 0, 0, 16, 1.f);
  add_seg(p, 2, 3072, K_PLAINB, p.G, 1024, 0, 0, 1.f);
  add_seg(p, 2, 4096, K_FLOG, nullptr, 0, 0, 0, 1.f);
  add_seg(p, 2, 4160, K_NONE, nullptr, 0, 0, 0, 1.f);
  add_seg(p, 3, 0, K_ROPE, p.Q, 1024, 0, 0, 0.125f);
  add_seg(p, 3, 1024, K_PLAIN, p.Kb, 256, 0, 0, 1.f);
  add_seg(p, 3, 1152, K_PLAIN, p.Kb + 128, 256, 0, 0, 1.f);
  add_seg(p, 3, 1280, K_ROPE, p.Kb + NT * 256, 128, 0, 0, 1.f);
  add_seg(p, 3, 1408, K_VT, p.Vt, 0, 0, 2, 1.f);
  add_seg(p, 3, 1536, K_ROPE, p.Kb + NT * 384, 128, 0, 0, 1.f);
  add_seg(p, 3, 1664, K_VT, p.Vt + NT * 128, 0, 0, 2, 1.f);
  add_seg(p, 3, 1792, K_PLAINB, p.G, 1024, 0, 0, 1.f);
  add_seg(p, 3, 2816, K_GLOG, nullptr, 0, 0, 0, 1.f);
  add_seg(p, 3, 2880, K_NONE, nullptr, 0, 0, 0, 1.f);
  void* args[] = {&p};
  hipError_t e = hipLaunchCooperativeKernel((const void*)mega_kernel, dim3(grid_blocks), dim3(256), args, LDS_BYTES, stream);
  if (e != hipSuccess) fprintf(stderr, "cooperative launch failed: %s (grid %d)\n", hipGetErrorString(e), grid_blocks);
}
```
